# Optimizing an MI355X kernel written in HIP

```python
import jax, jax.numpy as jnp
from jax import lax
import numpy as np

D_MODEL = 1024
BATCH = 16
SEQ = 256
DEPTH = 1
DEC_BATCH = 4
DEC_SEQ = 2048
PAST_LEN = 256

GRID_W = 64
LRU_HEADS = 8
LRU_WIDTH = D_MODEL // 2
LRU_HEAD_DIM = LRU_WIDTH // LRU_HEADS
LRU_CONV_W = 4
LRU_CONV_LEFT = 2
LRU_C = 8.0
SGU_GROUPS = 4
SGU_WIDTH = D_MODEL // 2
SGU_GROUP_DIM = SGU_WIDTH // SGU_GROUPS
CHUNK = 128
D_IN = 2 * LRU_WIDTH + 2 * SGU_WIDTH
D_MIX = LRU_WIDTH + SGU_WIDTH
D_FF = 3 * D_MODEL
FFN_CONV_W = 3
FFN_CONV_LEFT = 1
N_MOD = 6
EPS = 1e-6

kernel_name = "hybrid_rglru_sgu_prefix_diffusion_step"


def rms_norm(x, gain):
    xf = x.astype(jnp.float32)
    y = xf * lax.rsqrt(jnp.mean(xf * xf, axis=-1, keepdims=True) + EPS)
    return (y * gain.astype(jnp.float32)).astype(x.dtype)


def dw_conv(x, w, b, left):
    k_w = w.shape[0]
    n = x.shape[-2]
    pad = [(0, 0)] * (x.ndim - 2) + [(left, k_w - 1 - left), (0, 0)]
    xp = jnp.pad(x, pad)
    out = b + xp[..., 0:n, :] * w[0]
    for k in range(1, k_w):
        out = out + xp[..., k:k + n, :] * w[k]
    return out


def _lin_combine(earlier, later):
    a1, b1 = earlier
    a2, b2 = later
    return a1 * a2, a2 * b1 + b2


def rglru_direction(xc, h0, w_a, b_a, w_x, b_x, lam, reverse):
    bsz, n, _ = xc.shape
    xh = xc.reshape(bsz, n, LRU_HEADS, LRU_HEAD_DIM)
    r = jax.nn.sigmoid(jnp.einsum("bshi,hij->bshj", xh, w_a).reshape(bsz, n, LRU_WIDTH) + b_a)
    i = jax.nn.sigmoid(jnp.einsum("bshi,hij->bshj", xh, w_x).reshape(bsz, n, LRU_WIDTH) + b_x)
    log_a = -LRU_C * r * jax.nn.softplus(-lam)
    a = jnp.exp(log_a)
    b = jnp.sqrt(-jnp.expm1(2.0 * log_a)) * (i * xc)
    edge = n - 1 if reverse else 0
    b = b.at[:, edge].add(a[:, edge] * h0.astype(b.dtype))
    _, h = lax.associative_scan(_lin_combine, (a, b), axis=1, reverse=reverse)
    return h


def mixer(h, h0_fwd, h0_bwd, p):
    z = h @ p["w_in"]
    xr, yr, u, v = jnp.split(z, [LRU_WIDTH, 2 * LRU_WIDTH, 2 * LRU_WIDTH + SGU_WIDTH], axis=-1)
    xc = dw_conv(xr, p["lru_conv_w"], p["lru_conv_b"], LRU_CONV_LEFT)
    hf = rglru_direction(xc, h0_fwd, p["lru_wa"][0], p["lru_ba"][0], p["lru_wx"][0],
                         p["lru_bx"][0], p["lru_lam"][0], False)
    hb = rglru_direction(xc, h0_bwd, p["lru_wa"][1], p["lru_ba"][1], p["lru_wx"][1],
                         p["lru_bx"][1], p["lru_lam"][1], True)
    o_lru = jax.nn.gelu(yr) * (hf + hb)
    bsz, n, _ = v.shape
    u = jax.nn.gelu(u)
    vc = jax.nn.gelu(v).reshape(bsz, n // CHUNK, CHUNK, SGU_GROUPS, SGU_GROUP_DIM)
    s = jnp.einsum("gpq,bnqgc->bnpgc", p["sgu_ws"], vc) + p["sgu_bs"].T[:, :, None]
    o_sgu = u * s.reshape(bsz, n, SGU_WIDTH)
    o = jnp.concatenate([rms_norm(o_lru, p["g_lru"]), rms_norm(o_sgu, p["g_sgu"])], axis=-1)
    return o @ p["w_out"], hf[:, -1], hb[:, 0]


def conv_ffn(h, p, grid):
    z = h @ p["ffn_up"]
    bsz, n, f2 = z.shape
    if grid:
        rows = n // GRID_W
        z = dw_conv(z.reshape(bsz, rows, GRID_W, f2), p["ffn_conv_w"], p["ffn_conv_b"],
                    FFN_CONV_LEFT).reshape(bsz, n, f2)
    else:
        z = dw_conv(z, p["ffn_conv_w"], p["ffn_conv_b"], FFN_CONV_LEFT)
    g, val = jnp.split(z, 2, axis=-1)
    return (jax.nn.silu(g) * val) @ p["ffn_down"]


def layer(x, mod, h0_fwd, h0_bwd, p, grid):
    sh1, sc1, g1, sh2, sc2, g2 = jnp.split(mod, N_MOD, axis=-1)
    h = rms_norm(x, p["norm1"]) * (1 + sc1) + sh1
    o, hf, hb = mixer(h, h0_fwd, h0_bwd, p)
    x = x + g1 * o
    h = rms_norm(x, p["norm2"]) * (1 + sc2) + sh2
    x = x + g2 * conv_ffn(h, p, grid)
    return x, hf, hb


def setup_inputs(seed: int = 0) -> dict:
    key = jax.random.key(seed)
    ks = jax.random.split(key, 32)
    nrm = jax.random.normal
    u = jax.random.uniform(ks[0], (DEPTH, 2, LRU_WIDTH), minval=0.9, maxval=0.999)
    s = u ** (1.0 / LRU_C)
    lam = jnp.log(s) - jnp.log1p(-s)
    return {
        "x_prompt": nrm(ks[1], (BATCH, SEQ, D_MODEL), jnp.float32),
        "x_sample": nrm(ks[2], (DEC_BATCH, DEC_SEQ, D_MODEL), jnp.float32),
        "state_lru": 0.5 * nrm(ks[3], (DEC_BATCH, DEPTH, 2, LRU_WIDTH), jnp.float32),
        "c": nrm(ks[4], (DEC_BATCH, D_MODEL), jnp.float32),
        "c_ctx": nrm(ks[5], (D_MODEL,), jnp.float32),
        "norm1": 1.0 + 0.05 * nrm(ks[6], (DEPTH, D_MODEL), jnp.float32),
        "norm2": 1.0 + 0.05 * nrm(ks[7], (DEPTH, D_MODEL), jnp.float32),
        "w_ada": 0.3 * D_MODEL ** -0.5 * nrm(ks[8], (DEPTH, D_MODEL, N_MOD * D_MODEL), jnp.float32),
        "b_ada": 0.01 * nrm(ks[9], (DEPTH, N_MOD * D_MODEL), jnp.float32),
        "w_in": D_MODEL ** -0.5 * nrm(ks[10], (DEPTH, D_MODEL, D_IN), jnp.float32),
        "lru_conv_w": LRU_CONV_W ** -0.5 * nrm(ks[11], (DEPTH, LRU_CONV_W, LRU_WIDTH), jnp.float32),
        "lru_conv_b": 0.01 * nrm(ks[12], (DEPTH, LRU_WIDTH), jnp.float32),
        "lru_wa": LRU_HEAD_DIM ** -0.5 * nrm(ks[13], (DEPTH, 2, LRU_HEADS, LRU_HEAD_DIM, LRU_HEAD_DIM), jnp.float32),
        "lru_ba": 0.01 * nrm(ks[14], (DEPTH, 2, LRU_WIDTH), jnp.float32),
        "lru_wx": LRU_HEAD_DIM ** -0.5 * nrm(ks[15], (DEPTH, 2, LRU_HEADS, LRU_HEAD_DIM, LRU_HEAD_DIM), jnp.float32),
        "lru_bx": 0.01 * nrm(ks[16], (DEPTH, 2, LRU_WIDTH), jnp.float32),
        "lru_lam": lam.astype(jnp.float32),
        "sgu_ws": CHUNK ** -0.5 * nrm(ks[17], (DEPTH, SGU_GROUPS, CHUNK, CHUNK), jnp.float32),
        "sgu_bs": 1.0 + 0.1 * nrm(ks[18], (DEPTH, SGU_GROUPS, CHUNK), jnp.float32),
        "g_lru": 1.0 + 0.05 * nrm(ks[19], (DEPTH, LRU_WIDTH), jnp.float32),
        "g_sgu": 1.0 + 0.05 * nrm(ks[20], (DEPTH, SGU_WIDTH), jnp.float32),
        "w_out": D_MIX ** -0.5 * nrm(ks[21], (DEPTH, D_MIX, D_MODEL), jnp.float32),
        "ffn_up": D_MODEL ** -0.5 * nrm(ks[22], (DEPTH, D_MODEL, 2 * D_FF), jnp.float32),
        "ffn_conv_w": FFN_CONV_W ** -0.5 * nrm(ks[23], (DEPTH, FFN_CONV_W, 2 * D_FF), jnp.float32),
        "ffn_conv_b": 0.01 * nrm(ks[24], (DEPTH, 2 * D_FF), jnp.float32),
        "ffn_down": D_FF ** -0.5 * nrm(ks[25], (DEPTH, D_FF, D_MODEL), jnp.float32),
        "final_norm": 1.0 + 0.05 * nrm(ks[26], (D_MODEL,), jnp.float32),
    }


def reference(x_prompt, x_sample, state_lru, c, c_ctx, norm1, norm2, w_ada, b_ada, w_in,
              lru_conv_w, lru_conv_b, lru_wa, lru_ba, lru_wx, lru_bx, lru_lam, sgu_ws, sgu_bs,
              g_lru, g_sgu, w_out, ffn_up, ffn_conv_w, ffn_conv_b, ffn_down, final_norm):
    xp = x_prompt
    xs = x_sample
    zeros = jnp.zeros((x_prompt.shape[0], LRU_WIDTH), x_prompt.dtype)
    new_states = []
    for l in range(DEPTH):
        p = {
            "norm1": norm1[l], "norm2": norm2[l], "w_in": w_in[l],
            "lru_conv_w": lru_conv_w[l], "lru_conv_b": lru_conv_b[l],
            "lru_wa": lru_wa[l], "lru_ba": lru_ba[l], "lru_wx": lru_wx[l], "lru_bx": lru_bx[l],
            "lru_lam": lru_lam[l], "sgu_ws": sgu_ws[l], "sgu_bs": sgu_bs[l],
            "g_lru": g_lru[l], "g_sgu": g_sgu[l], "w_out": w_out[l],
            "ffn_up": ffn_up[l], "ffn_conv_w": ffn_conv_w[l], "ffn_conv_b": ffn_conv_b[l],
            "ffn_down": ffn_down[l],
        }
        mod_ctx = (jax.nn.silu(c_ctx) @ w_ada[l] + b_ada[l])[None, None, :]
        mod_lat = (jax.nn.silu(c) @ w_ada[l] + b_ada[l])[:, None, :]
        xp, hf, hb = layer(xp, mod_ctx, zeros, zeros, p, False)
        new_states.append(jnp.stack([hf, hb], axis=1))
        xs, _, _ = layer(xs, mod_lat, state_lru[:, l, 0], state_lru[:, l, 1], p, True)
    y_prompt = rms_norm(xp, final_norm)
    y_sample = rms_norm(xs, final_norm)
    new_state_lru = jnp.stack(new_states, axis=1)
    return (y_prompt, y_sample, new_state_lru)
```

```cpp
#include <hip/hip_runtime.h>
#include <hip/hip_cooperative_groups.h>
#include <cstdio>
namespace cg = cooperative_groups;

#ifndef ONE_LAUNCH
#define ONE_LAUNCH 1
#endif

#define LAS __attribute__((address_space(3)))
typedef unsigned short bf16_t;
typedef short bf16x8 __attribute__((ext_vector_type(8)));
typedef float f32x4 __attribute__((ext_vector_type(4)));
typedef float f32x2 __attribute__((ext_vector_type(2)));
typedef unsigned u32x4 __attribute__((ext_vector_type(4)));
typedef unsigned u32x2 __attribute__((ext_vector_type(2)));

constexpr int DM = 1024, NTOK = 12288, NCTX = 4096, DIN = 2048, DFF = 3072, DFF2 = 6144;
constexpr float EPS = 1e-6f;
constexpr int NTHREADS = 512;
constexpr int LDS_BYTES = 131072 + 16384;
constexpr int EX_OFF = 131072;

constexpr size_t WS_BT1 = 0;
constexpr size_t WS_BT2 = 4194304;
constexpr size_t WS_BT3 = 6291456;
constexpr size_t WS_BT4 = 18874368;
constexpr size_t WS_WG = 25165824;
constexpr size_t WS_MOD = 25427968;
constexpr size_t WS_SHW = 25550848;
constexpr size_t WS_SUMA = 25673728;
constexpr size_t WS_SUMB = 27246592;
constexpr size_t WS_SGP = 28819456;
constexpr size_t WS_SSQ2 = 29016064;
constexpr size_t WS_SSQ4 = 29802496;
constexpr size_t WS_BAR = 30588928;
constexpr size_t WS_SP8 = WS_BAR + 65536;
constexpr size_t WS_H1 = 33554432;
constexpr size_t WS_H2 = 58720256;
constexpr size_t WS_Z = 83886080;
constexpr size_t WS_OSGU = 134217728;
constexpr size_t WS_ACT = WS_Z;
constexpr size_t WS_X1 = 167772160;
constexpr size_t WS_HS = WS_X1;
constexpr size_t WS_AC = WS_X1 + 25165824;
constexpr size_t WS_END = WS_X1 + 50331648;

struct P { const float* in[27]; float* out; unsigned char* ws; int ph_lo, ph_hi; };
typedef const __attribute__((address_space(4))) P* KP;
__device__ __forceinline__ KP kargs() { KP kp = (KP)__builtin_amdgcn_kernarg_segment_ptr(); asm volatile("" : "+s"(kp)); return kp; }

__device__ __forceinline__ unsigned cvt_pk_bf16(float lo, float hi) { unsigned r; asm volatile("v_cvt_pk_bf16_f32 %0, %1, %2" : "=v"(r) : "v"(lo), "v"(hi)); return r; }
__device__ __forceinline__ float bf2f(unsigned short h) { return __uint_as_float(((unsigned)h) << 16); }
__device__ __forceinline__ float bflo(unsigned w) { return __uint_as_float(w << 16); }
__device__ __forceinline__ float bfhi(unsigned w) { return __uint_as_float(w & 0xffff0000u); }
__device__ __forceinline__ float frcp(float x) { return __builtin_amdgcn_rcpf(x); }
__device__ __forceinline__ float sigmoidf_(float x) { return frcp(1.0f + __expf(-x)); }
__device__ __forceinline__ float siluf_(float x) { return x * frcp(1.0f + __expf(-x)); }
__device__ __forceinline__ float geluf_(float x) { const float u = 1.5957691216f * (x + 0.044715f * x * x * x); return x * frcp(1.0f + __expf(-u)); }
__device__ __forceinline__ float shfl_f(float v, int srclane) { return __int_as_float(__builtin_amdgcn_ds_bpermute(srclane << 2, __float_as_int(v))); }
template <int CTRL> __device__ __forceinline__ float dpp_f(float old, float src) { return __int_as_float(__builtin_amdgcn_update_dpp(__float_as_int(old), __float_as_int(src), CTRL, 0xf, 0xf, false)); }
__device__ __forceinline__ int lane_id() { int l; asm volatile("v_mbcnt_lo_u32_b32 %0, -1, 0\n\tv_mbcnt_hi_u32_b32 %0, -1, %0" : "=v"(l)); return l; }
__device__ __forceinline__ int bidx_of_row(int t) { return t < NCTX ? 0 : 1 + ((t - NCTX) >> 11); }

namespace pg8 {
constexpr int BM = 256, BK = 64, HALF = 128, HTB = HALF * BK * 2, STAGE_BYTES = 8 * HTB, NXCD = 8, WGM = 8;
__host__ __device__ __forceinline__ int lds_byte(int r, int c) { const int st = (r >> 4) * 2 + (c >> 5), rr = r & 15, cc = c & 31, ob = rr * 64 + cc * 2; return st * 1024 + (ob ^ (((ob >> 9) & 1) << 5)); }
__host__ __device__ __forceinline__ void stage_rc(int b, int& R, int& C) { const int st = b / 1024, sb = b % 1024, swz = sb ^ (((sb >> 9) & 1) << 5); R = (st >> 1) * 16 + swz / 64; C = (st & 1) * 32 + (swz % 64) / 2; }
__host__ __device__ __forceinline__ int perm32(int rho) { const int n = rho >> 4, i = rho & 15; return 8 * (i >> 2) + 4 * n + (i & 3); }
struct Unit { int pm, pn; };
struct Gemm { const bf16_t* A; const bf16_t* Bt; int M, N, K; };
struct StaticOrder {
    int nM, nN, nwg, G, c;
    __device__ void init(int M, int N, int G_, int c_, int RM = BM) { nM = M / RM; nN = N / BM; nwg = nM * nN; G = G_; c = c_; }
    __device__ bool next(int i, Unit& u) const {
        const long L = (long)i * G + c; if (L >= nwg) return false;
        int wgid = (int)L; { const int q = nwg / NXCD, r = nwg % NXCD, xcd = wgid % NXCD, off = wgid / NXCD; wgid = (xcd < r ? xcd * (q + 1) : r * (q + 1) + (xcd - r) * q) + off; }
        const int nig = WGM * nN, gid = wgid / nig, fm = gid * WGM, gsz = (nM - fm) < WGM ? (nM - fm) : WGM;
        u.pm = fm + ((wgid % nig) % gsz); u.pn = (wgid % nig) / gsz; return true;
    }
};

template <class Epi, int MB = 4>
__device__ __forceinline__ void gemm_phase(LAS unsigned char* lds, const Gemm g, const StaticOrder& S, const Epi& E, const int wave_) {
    const int wid = wave_, lane = lane_id(), tid = wid * 64 + lane, wr = wid >> 2, wc = wid & 3, fr = lane & 15, fq = lane >> 4;
    const int K = g.K, nt = K / BK;
    unsigned voffA[2], voffB[2];
#pragma unroll
    for (int i = 0; i < 2; ++i) { int R, C; stage_rc(tid * 16 + i * 8192, R, C); const int Rb = Epi::PERM ? ((R & ~31) + perm32(R & 31)) : R;
        voffA[i] = (unsigned)(R * K + C) * 2u; voffB[i] = (unsigned)(Rb * K + C) * 2u; }
    const size_t kstep = (size_t)(BK * 2);
    const size_t hstep = (size_t)HALF * K * 2;
    const size_t tstep = 2 * hstep;
    const size_t hstepA = (size_t)(32 * MB) * K * 2, tstepA = 2 * hstepA;
    const unsigned ldsw = (unsigned)wid * 1024u;
    const int aoff = lds_byte(wr * 16 * MB + fr, fq * 8), boff = lds_byte(wc * 32 + fr, fq * 8);
#define PG8_SA(b, h) (((b) * 2 + (h)) * HTB)
#define PG8_SB(b, h) ((4 + (b) * 2 + (h)) * HTB)
#define PG8_STAGE(bufoff, gbase, voff) do { _Pragma("unroll") for (int _i = 0; _i < 2; ++_i) \
        __builtin_amdgcn_global_load_lds((const unsigned*)((const char*)(gbase) + (voff)[_i]), (LAS unsigned*)(lds + (bufoff) + ldsw + _i * 8192), 16, 0, 0); } while (0)
#define PG8_LDA(dst, b, h) do { _Pragma("unroll") for (int m = 0; m < MB; ++m) _Pragma("unroll") for (int k = 0; k < 2; ++k) dst[m][k] = *(const LAS bf16x8*)(lds + PG8_SA(b, h) + aoff + m * 2048 + k * 1024); } while (0)
#define PG8_LDB(dst, b, h) do { _Pragma("unroll") for (int n = 0; n < 2; ++n) _Pragma("unroll") for (int k = 0; k < 2; ++k) dst[n][k] = *(const LAS bf16x8*)(lds + PG8_SB(b, h) + boff + n * 2048 + k * 1024); } while (0)
#define PG8_MMA(ai, bj, At, Bt) do { __builtin_amdgcn_s_setprio(1); _Pragma("unroll") for (int m = 0; m < MB; ++m) _Pragma("unroll") for (int n = 0; n < 2; ++n) _Pragma("unroll") for (int k = 0; k < 2; ++k) \
        acc[ai][bj][m][n] = __builtin_amdgcn_mfma_f32_16x16x32_bf16(Bt[n][k], At[m][k], acc[ai][bj][m][n], 0, 0, 0); __builtin_amdgcn_s_setprio(0); } while (0)
#define PG8_WAIT_V(n) asm volatile("s_waitcnt vmcnt(" #n ")" ::: "memory")
#define PG8_WAIT_L(n) asm volatile("s_waitcnt lgkmcnt(" #n ")" ::: "memory")
#define PG8_BAR __builtin_amdgcn_s_barrier()
#define PG8_SCHED __builtin_amdgcn_sched_barrier(0)
    Unit cur, nxt; int ui = 0;
    if (!S.next(0, cur)) return;
    f32x4 acc[2][2][MB][2];
#pragma unroll
    for (int a = 0; a < 2; ++a)
#pragma unroll
        for (int b = 0; b < 2; ++b)
#pragma unroll
            for (int m = 0; m < MB; ++m)
#pragma unroll
                for (int n = 0; n < 2; ++n) acc[a][b][m][n] = (f32x4){0.f, 0.f, 0.f, 0.f};
    bf16x8 At[MB][2], B0[2][2], B1[2][2];
    const char* cA = (const char*)g.A + (size_t)cur.pm * tstepA; const char* cB = (const char*)g.Bt + (size_t)cur.pn * tstep;
    PG8_STAGE(PG8_SB(0, 0), cB, voffB); PG8_STAGE(PG8_SA(0, 0), cA, voffA); PG8_STAGE(PG8_SB(0, 1), cB + hstep, voffB); PG8_STAGE(PG8_SA(0, 1), cA + hstepA, voffA);
    if (wr == 1) PG8_BAR;
    PG8_WAIT_V(4); PG8_BAR;
    PG8_STAGE(PG8_SB(1, 0), cB + kstep, voffB); PG8_STAGE(PG8_SA(1, 0), cA + kstep, voffA); PG8_STAGE(PG8_SB(1, 1), cB + hstep + kstep, voffB);
    PG8_WAIT_V(6); PG8_BAR;
    for (;;) {
        const bool has_next = S.next(ui + 1, nxt);
        const char* nA = has_next ? (const char*)g.A + (size_t)nxt.pm * tstepA : cA; const char* nB = has_next ? (const char*)g.Bt + (size_t)nxt.pn * tstep : cB;
        for (int t = 0; t < nt; t += 2) {
            const bool last = (t == nt - 2);
            const char* a1 = cA + (size_t)(t + 1) * kstep;
            const char* a2 = last ? nA : cA + (size_t)(t + 2) * kstep; const char* b2 = last ? nB : cB + (size_t)(t + 2) * kstep;
            const char* a3 = a2 + kstep; const char* b3 = b2 + kstep;
            PG8_LDB(B0, 0, 0); PG8_SCHED; PG8_LDA(At, 0, 0); PG8_STAGE(PG8_SA(1, 1), a1 + hstepA, voffA);
            PG8_WAIT_L(8); PG8_BAR; PG8_WAIT_L(0); PG8_MMA(0, 0, At, B0); PG8_BAR; PG8_SCHED;
            PG8_LDB(B1, 0, 1); PG8_STAGE(PG8_SB(0, 0), b2, voffB);
            PG8_BAR; PG8_WAIT_L(0); PG8_MMA(0, 1, At, B1); PG8_BAR;
            PG8_LDA(At, 0, 1); PG8_STAGE(PG8_SA(0, 0), a2, voffA);
            PG8_BAR; PG8_WAIT_L(0); PG8_MMA(1, 0, At, B0); PG8_BAR; PG8_SCHED;
            PG8_STAGE(PG8_SB(0, 1), b2 + hstep, voffB);
            PG8_WAIT_V(6); PG8_BAR; PG8_MMA(1, 1, At, B1); PG8_BAR;
            PG8_LDB(B0, 1, 0); PG8_SCHED; PG8_LDA(At, 1, 0); PG8_STAGE(PG8_SA(0, 1), a2 + hstepA, voffA);
            PG8_WAIT_L(8); PG8_BAR; PG8_WAIT_L(0); PG8_MMA(0, 0, At, B0); PG8_BAR; PG8_SCHED;
            PG8_LDB(B1, 1, 1); PG8_STAGE(PG8_SB(1, 0), b3, voffB);
            PG8_BAR; PG8_WAIT_L(0); PG8_MMA(0, 1, At, B1); PG8_BAR;
            PG8_LDA(At, 1, 1); PG8_STAGE(PG8_SA(1, 0), a3, voffA);
            PG8_BAR; PG8_WAIT_L(0); PG8_MMA(1, 0, At, B0); PG8_BAR; PG8_SCHED;
            PG8_STAGE(PG8_SB(1, 1), b3 + hstep, voffB);
            PG8_WAIT_V(6); PG8_BAR; PG8_MMA(1, 1, At, B1); PG8_BAR;
        }
        if constexpr (!Epi::AFTER_DRAIN) E(acc, cur, wr, wc, fr, fq);
        if (!has_next) break;
#pragma unroll
        for (int a = 0; a < 2; ++a)
#pragma unroll
            for (int b = 0; b < 2; ++b)
#pragma unroll
                for (int m = 0; m < MB; ++m)
#pragma unroll
                    for (int n = 0; n < 2; ++n) acc[a][b][m][n] = (f32x4){0.f, 0.f, 0.f, 0.f};
        cur = nxt; cA = nA; cB = nB; ++ui;
    }
    PG8_WAIT_V(0);
    if (wr == 0) PG8_BAR;
    PG8_BAR;
    if constexpr (Epi::AFTER_DRAIN) E.fused(acc, cur, wr, wc, fr, fq, lds, wid, lane);
#undef PG8_SA
#undef PG8_SB
#undef PG8_STAGE
#undef PG8_LDA
#undef PG8_LDB
#undef PG8_MMA
#undef PG8_WAIT_V
#undef PG8_WAIT_L
#undef PG8_BAR
#undef PG8_SCHED
}
}
using pg8::Unit;


template <int MB> struct EpiZ {
    static constexpr bool PERM = true, AFTER_DRAIN = false;
    bf16_t* O;
    __device__ __forceinline__ void operator()(const f32x4 (&acc)[2][2][MB][2], const Unit& u, int wr, int wc, int fr, int fq) const {
        const int row0 = u.pm * 64 * MB + wr * 16 * MB + fr, col0 = u.pn * 256 + wc * 32 + 8 * fq;
#pragma unroll
        for (int ai = 0; ai < 2; ++ai)
#pragma unroll
            for (int m = 0; m < MB; ++m) { bf16_t* rowp = O + (size_t)(row0 + ai * 32 * MB + m * 16) * DIN + col0;
#pragma unroll
                for (int bj = 0; bj < 2; ++bj) { const f32x4 v0 = acc[ai][bj][m][0], v1 = acc[ai][bj][m][1];
                    u32x4 w; w.x = cvt_pk_bf16(v0[0], v0[1]); w.y = cvt_pk_bf16(v0[2], v0[3]); w.z = cvt_pk_bf16(v1[0], v1[1]); w.w = cvt_pk_bf16(v1[2], v1[3]);
                    *(u32x4*)(rowp + bj * 128) = w; } }
    }
};

template <int MB> struct EpiG2 {
    static constexpr bool PERM = true, AFTER_DRAIN = false;
    const float* xp; const float* xs; const float* mod; const float* norm2; float* out; bf16_t* h2; float* ssq;
    __device__ __forceinline__ void operator()(const f32x4 (&acc)[2][2][MB][2], const Unit& u, int wr, int wc, int fr, int fq) const {
        const int rb0 = u.pm * 64 * MB + wr * 16 * MB, col0 = u.pn * 256 + wc * 32 + 8 * fq, lane = fr + 16 * fq;
        f32x4 nv[2][2];
#pragma unroll
        for (int bj = 0; bj < 2; ++bj)
#pragma unroll
            for (int n = 0; n < 2; ++n) nv[bj][n] = *(const f32x4*)(norm2 + col0 + bj * 128 + 4 * n);
#pragma unroll
        for (int ai = 0; ai < 2; ++ai)
#pragma unroll
            for (int m = 0; m < MB; ++m) { const int rb = rb0 + ai * 32 * MB + m * 16, row = rb + fr; const int b = bidx_of_row(rb);
                const float* mb = mod + b * 6144 + col0;
                const float* xr = (rb < NCTX ? xp + (size_t)row * DM : xs + (size_t)(row - NCTX) * DM) + col0;
                const size_t off = (size_t)row * DM + col0; float ss = 0.f;
#pragma unroll
                for (int bj = 0; bj < 2; ++bj) {
                    const f32x4 x0 = *(const f32x4*)(xr + bj * 128), x1 = *(const f32x4*)(xr + bj * 128 + 4);
                    const f32x4 g0 = *(const f32x4*)(mb + 2048 + bj * 128), g1 = *(const f32x4*)(mb + 2048 + bj * 128 + 4);
                    const f32x4 c0 = *(const f32x4*)(mb + 4096 + bj * 128), c1 = *(const f32x4*)(mb + 4096 + bj * 128 + 4);
                    const f32x4 v0 = x0 + g0 * acc[ai][bj][m][0], v1 = x1 + g1 * acc[ai][bj][m][1];
                    *(f32x4*)(out + off + bj * 128) = v0; *(f32x4*)(out + off + bj * 128 + 4) = v1;
                    ss += (v0[0] * v0[0] + v0[1] * v0[1]) + (v0[2] * v0[2] + v0[3] * v0[3]) + (v1[0] * v1[0] + v1[1] * v1[1]) + (v1[2] * v1[2] + v1[3] * v1[3]);
                    const f32x4 h0 = v0 * (nv[bj][0] * (c0 + 1.0f)), h1 = v1 * (nv[bj][1] * (c1 + 1.0f));
                    u32x4 w; w.x = cvt_pk_bf16(h0[0], h0[1]); w.y = cvt_pk_bf16(h0[2], h0[3]); w.z = cvt_pk_bf16(h1[0], h1[1]); w.w = cvt_pk_bf16(h1[2], h1[3]);
                    *(u32x4*)(h2 + off + bj * 128) = w; }
                ss += shfl_f(ss, lane ^ 16); ss += shfl_f(ss, lane ^ 32);
                if (fq == 0) ssq[(size_t)row * 16 + u.pn * 4 + wc] = ss; }
    }
};

template <int MB> struct EpiG4 {
    static constexpr bool PERM = true, AFTER_DRAIN = true;
    const float* mod; const float* x1; const float* fnorm; float* out; unsigned* slot; unsigned* cnt;
    __device__ __forceinline__ void fused(f32x4 (&acc)[2][2][MB][2], const Unit& u, int wr, int wc, int fr, int fq, LAS unsigned char* lds, int wid, int lane) const {
        constexpr int RM = 64 * MB;
        const int rl0 = wr * 16 * MB + fr, row0 = u.pm * RM + rl0, col0 = u.pn * 256 + wc * 32 + 8 * fq, tid = wid * 64 + lane;
        LAS float* Pt = (LAS float*)lds;
        LAS float* St = (LAS float*)(lds + 4096);
#pragma unroll
        for (int ai = 0; ai < 2; ++ai)
#pragma unroll
            for (int m = 0; m < MB; ++m) { const int dr = ai * 32 * MB + m * 16; const size_t off = (size_t)(row0 + dr) * DM + col0; float ss = 0.f;
                const float* mb = mod + bidx_of_row(u.pm * RM + wr * 16 * MB + dr) * 6144 + 5120 + col0;
#pragma unroll
                for (int bj = 0; bj < 2; ++bj) {
                    const f32x4 x0 = *(const f32x4*)(x1 + off + bj * 128), xb1 = *(const f32x4*)(x1 + off + bj * 128 + 4);
                    const f32x4 g0 = *(const f32x4*)(mb + bj * 128), g1 = *(const f32x4*)(mb + bj * 128 + 4);
                    const f32x4 v0 = x0 + g0 * acc[ai][bj][m][0], v1 = xb1 + g1 * acc[ai][bj][m][1];
                    acc[ai][bj][m][0] = v0; acc[ai][bj][m][1] = v1;
                    ss += (v0[0] * v0[0] + v0[1] * v0[1]) + (v0[2] * v0[2] + v0[3] * v0[3]) + (v1[0] * v1[0] + v1[1] * v1[1]) + (v1[2] * v1[2] + v1[3] * v1[3]); }
                ss += shfl_f(ss, lane ^ 16); ss += shfl_f(ss, lane ^ 32);
                if (fq == 0) Pt[(dr + rl0) * 4 + wc] = ss; }
        asm volatile("s_waitcnt lgkmcnt(0)" ::: "memory"); __builtin_amdgcn_s_barrier(); asm volatile("" ::: "memory");
        if (tid < RM) { const f32x4 pr = *(const LAS f32x4*)(Pt + tid * 4); const float tot = (pr[0] + pr[1]) + (pr[2] + pr[3]);
            __hip_atomic_store(slot + (size_t)(u.pm * RM + tid) * 4 + u.pn, __float_as_uint(tot), __ATOMIC_RELAXED, __HIP_MEMORY_SCOPE_AGENT); }
        asm volatile("s_waitcnt vmcnt(0)" ::: "memory");
        if (wid < MB && lane == 0) __hip_atomic_fetch_add(cnt + 64 * u.pm, 1u, __ATOMIC_RELAXED, __HIP_MEMORY_SCOPE_AGENT);
        if (wid == 0) { unsigned sp = 0;
            while ((unsigned)__builtin_amdgcn_readfirstlane(__hip_atomic_load(cnt + 64 * u.pm, __ATOMIC_RELAXED, __HIP_MEMORY_SCOPE_AGENT)) < 4u * MB) { __builtin_amdgcn_s_sleep(2); if (++sp > (1u << 22)) break; }
            __builtin_amdgcn_fence(__ATOMIC_ACQUIRE, "agent");
            asm volatile("s_waitcnt vmcnt(0)" ::: "memory"); }
        asm volatile("s_waitcnt lgkmcnt(0)" ::: "memory"); __builtin_amdgcn_s_barrier(); asm volatile("" ::: "memory");
        if (tid < RM) { const unsigned* sl = slot + (size_t)(u.pm * RM + tid) * 4; float tot = 0.f;
#pragma unroll
            for (int t = 0; t < 4; ++t) tot += __uint_as_float(__hip_atomic_load(sl + t, __ATOMIC_RELAXED, __HIP_MEMORY_SCOPE_AGENT));
            St[tid] = __builtin_amdgcn_rsqf(tot * (1.0f / 1024.0f) + EPS); }
        asm volatile("s_waitcnt lgkmcnt(0)" ::: "memory"); __builtin_amdgcn_s_barrier(); asm volatile("" ::: "memory");
        f32x4 fn[2][2];
#pragma unroll
        for (int bj = 0; bj < 2; ++bj)
#pragma unroll
            for (int n = 0; n < 2; ++n) fn[bj][n] = *(const f32x4*)(fnorm + col0 + bj * 128 + 4 * n);
#pragma unroll
        for (int ai = 0; ai < 2; ++ai)
#pragma unroll
            for (int m = 0; m < MB; ++m) { const int dr = ai * 32 * MB + m * 16; const size_t off = (size_t)(row0 + dr) * DM + col0; const float inv = St[dr + rl0];
#pragma unroll
                for (int bj = 0; bj < 2; ++bj) { *(f32x4*)(out + off + bj * 128) = acc[ai][bj][m][0] * inv * fn[bj][0]; *(f32x4*)(out + off + bj * 128 + 4) = acc[ai][bj][m][1] * inv * fn[bj][1]; } }
    }
};

struct EpiG3 {
    static constexpr bool PERM = true, AFTER_DRAIN = false;
    const float* ssq2; const float* shw; const float* cw; const float* cb; bf16_t* act; LAS float* ex;
    __device__ __forceinline__ void operator()(f32x4 (&acc)[2][2][4][2], const Unit& u, int wr, int wc, int fr_, int fq_) const {
        const bool ctx = u.pm < 16;
        const int b = ctx ? 0 : 1 + ((u.pm - 16) >> 3);
        int lane; asm volatile("v_mbcnt_lo_u32_b32 %0, -1, 0\n\tv_mbcnt_hi_u32_b32 %0, -1, %0" : "=v"(lane));
        const int fr = lane & 15, fq = lane >> 4;
        const int row0 = u.pm * 256 + wr * 64 + fr;
        f32x4 cst[2][4][2];
#pragma unroll
        for (int bj = 0; bj < 2; ++bj) { const unsigned co = bj * DFF + u.pn * 128 + wc * 32 + 8 * fq;
            cst[0][0][bj] = *(const f32x4*)(cw + co); cst[0][1][bj] = *(const f32x4*)(cw + DFF2 + co); cst[0][2][bj] = *(const f32x4*)(cw + 2 * DFF2 + co); cst[0][3][bj] = *(const f32x4*)(cb + co); }
        {
            f32x4 sq[2][4];
#pragma unroll
            for (int ai = 0; ai < 2; ++ai)
#pragma unroll
                for (int m = 0; m < 4; ++m) sq[ai][m] = *(const f32x4*)(ssq2 + (unsigned)((row0 + ai * 128 + m * 16) * 16 + 4 * fq));
            float inv[2][4];
#pragma unroll
            for (int ai = 0; ai < 2; ++ai)
#pragma unroll
                for (int m = 0; m < 4; ++m) { float t = (sq[ai][m][0] + sq[ai][m][1]) + (sq[ai][m][2] + sq[ai][m][3]);
                    t += shfl_f(t, lane ^ 16); t += shfl_f(t, lane ^ 32);
                    inv[ai][m] = __builtin_amdgcn_rsqf(t * (1.0f / 1024.0f) + EPS); }
#pragma unroll
            for (int bj = 0; bj < 2; ++bj)
#pragma unroll
                for (int n = 0; n < 2; ++n) { const f32x4 sh = *(const f32x4*)(shw + (unsigned)(b * 6144 + u.pn * 256 + bj * 128 + wc * 32 + 8 * fq + 4 * n));
#pragma unroll
                    for (int ai = 0; ai < 2; ++ai)
#pragma unroll
                        for (int m = 0; m < 4; ++m) acc[ai][bj][m][n] = acc[ai][bj][m][n] * inv[ai][m] + sh; }
#pragma unroll
            for (int ai = 0; ai < 2; ++ai)
#pragma unroll
                for (int m = 0; m < 4; ++m) asm volatile("" : "+v"(acc[ai][0][m][0]), "+v"(acc[ai][0][m][1]), "+v"(acc[ai][1][m][0]), "+v"(acc[ai][1][m][1]));
        }
        if (ctx) {
            if (fr == 0) {
#pragma unroll
                for (int ai = 0; ai < 2; ++ai)
#pragma unroll
                    for (int bj = 0; bj < 2; ++bj)
#pragma unroll
                        for (int n = 0; n < 2; ++n) *(LAS f32x4*)(ex + ((2 * ai + wr) * 2 + 0) * 256 + bj * 128 + wc * 32 + 8 * fq + 4 * n) = acc[ai][bj][0][n];
            }
            if (fr == 15) {
#pragma unroll
                for (int ai = 0; ai < 2; ++ai)
#pragma unroll
                    for (int bj = 0; bj < 2; ++bj)
#pragma unroll
                        for (int n = 0; n < 2; ++n) *(LAS f32x4*)(ex + ((2 * ai + wr) * 2 + 1) * 256 + bj * 128 + wc * 32 + 8 * fq + 4 * n) = acc[ai][bj][3][n];
            }
            asm volatile("s_waitcnt lgkmcnt(0)" ::: "memory"); __builtin_amdgcn_s_barrier(); asm volatile("" ::: "memory");
            __builtin_amdgcn_s_barrier(); asm volatile("" ::: "memory");
        }
#pragma unroll
        for (int bj = 0; bj < 2; ++bj) { const unsigned co = bj * DFF + u.pn * 128 + wc * 32 + 8 * fq + 4;
            cst[1][0][bj] = *(const f32x4*)(cw + co); cst[1][1][bj] = *(const f32x4*)(cw + DFF2 + co); cst[1][2][bj] = *(const f32x4*)(cw + 2 * DFF2 + co); cst[1][3][bj] = *(const f32x4*)(cb + co); }
#pragma unroll
        for (int ai = 0; ai < 2; ++ai) {
            u32x2 keep[4];
#pragma unroll
            for (int n = 0; n < 2; ++n) {
                const int s = 2 * ai + wr;
                f32x4 og[4];
#pragma unroll
                for (int bj = 0; bj < 2; ++bj) {
                    const f32x4 w0 = cst[n][0][bj], w1 = cst[n][1][bj], w2 = cst[n][2][bj], cbv = cst[n][3][bj];
                    f32x4 pv = (f32x4){0.f, 0.f, 0.f, 0.f}, nv = (f32x4){0.f, 0.f, 0.f, 0.f};
                    if (ctx) { const int cl = bj * 128 + wc * 32 + 8 * fq + 4 * n;
                        if (s > 0) pv = *(const LAS f32x4*)(ex + ((s - 1) * 2 + 1) * 256 + cl);
                        if (s < 3) nv = *(const LAS f32x4*)(ex + ((s + 1) * 2 + 0) * 256 + cl); }
#pragma unroll
                    for (int m = 0; m < 4; ++m) {
                        f32x4 o;
#pragma unroll
                        for (int j = 0; j < 4; ++j) {
                            const float zc = acc[ai][bj][m][n][j];
                            const float oldp = m > 0 ? __int_as_float(__builtin_amdgcn_mov_dpp(__float_as_int(acc[ai][bj][m > 0 ? m - 1 : 0][n][j]), 0x121, 0xf, 0xf, false)) : pv[j];
                            const float prev = dpp_f<0x111>(oldp, zc);
                            const float oldn = m < 3 ? __int_as_float(__builtin_amdgcn_mov_dpp(__float_as_int(acc[ai][bj][m < 3 ? m + 1 : 3][n][j]), 0x12F, 0xf, 0xf, false)) : nv[j];
                            const float next = dpp_f<0x101>(oldn, zc);
                            o[j] = cbv[j] + w0[j] * prev + w1[j] * zc + w2[j] * next;
                        }
                        if (bj == 0) {
#pragma unroll
                            for (int j = 0; j < 4; ++j) og[m][j] = siluf_(o[j]);
                        } else {
                            const f32x4 a = og[m] * o;
                            u32x2 w; w.x = cvt_pk_bf16(a[0], a[1]); w.y = cvt_pk_bf16(a[2], a[3]);
                            if (n == 0) keep[m] = w;
                            else { u32x4 ww; ww.x = keep[m].x; ww.y = keep[m].y; ww.z = w.x; ww.w = w.y;
                                *(u32x4*)(act + (unsigned)((row0 + ai * 128 + m * 16) * DFF + u.pn * 128 + wc * 32 + 8 * fq)) = ww; }
                        }
                    }
                    asm volatile("" ::: "memory");
                }
            }
        }
    }
};

__device__ __forceinline__ void p0_mod_item(KP p, LAS unsigned char* lds, int item, const int wave) {
    const int lane = lane_id(), tid = wave * 64 + lane;
    LAS float* sc = (LAS float*)lds;
    LAS float* red = (LAS float*)(lds + 20480);
    const float* c = p->in[3]; const float* cctx = p->in[4]; const float* wada = p->in[7]; const float* bada = p->in[8];
    float* mod = (float*)(p->ws + WS_MOD);
    for (int i = tid; i < 5120; i += NTHREADS) { const int b = i >> 10, k = i & 1023; const float v = b == 0 ? cctx[k] : c[(b - 1) * 1024 + k]; sc[i] = siluf_(v); }
    __syncthreads();
    const int col0 = item * 32, cq = lane & 7, rg = lane >> 3;
    float acc[5][4];
#pragma unroll
    for (int b = 0; b < 5; ++b)
#pragma unroll
        for (int j = 0; j < 4; ++j) acc[b][j] = 0.f;
    const float* wp = wada + col0 + 4 * cq;
#pragma unroll 4
    for (int s = 0; s < 16; ++s) { const int k = 64 * s + 8 * wave + rg; const f32x4 w = *(const f32x4*)(wp + (size_t)k * 6144);
#pragma unroll
        for (int b = 0; b < 5; ++b) { const float sb = sc[b * 1024 + k];
#pragma unroll
            for (int j = 0; j < 4; ++j) acc[b][j] += sb * w[j]; } }
#pragma unroll
    for (int b = 0; b < 5; ++b)
#pragma unroll
        for (int j = 0; j < 4; ++j) { float v = acc[b][j]; v += shfl_f(v, lane ^ 8); v += shfl_f(v, lane ^ 16); v += shfl_f(v, lane ^ 32); if (rg == 0) red[(wave * 5 + b) * 32 + 4 * cq + j] = v; }
    __syncthreads();
    if (tid < 160) { const int b = tid >> 5, cc = tid & 31; float s = 0.f;
#pragma unroll
        for (int w = 0; w < 8; ++w) s += red[(w * 5 + b) * 32 + cc];
        mod[b * 6144 + col0 + cc] = s + bada[col0 + cc]; }
    __syncthreads();
}

struct TrTile { const float* src; bf16_t* dst; int N, k0, n0, Kd, drow0; };
__device__ __forceinline__ TrTile p0_tile_desc(KP p, int idx) {
    TrTile t;
    if (idx < 512) { const int kt = idx >> 5, nt = idx & 31; t = TrTile{p->in[9], (bf16_t*)(p->ws + WS_BT1), DIN, 64 * kt, 64 * nt, 1024, 64 * nt}; }
    else if (idx < 768) { idx -= 512; const int kt = idx >> 4, nt = idx & 15; t = TrTile{p->in[21], (bf16_t*)(p->ws + WS_BT2), DM, 64 * kt, 64 * nt, 1024, 64 * nt}; }
    else if (idx < 2304) { idx -= 768; const int kt = idx / 96, nt = idx % 96; const int n0 = 64 * nt; const int nn = n0 < DFF ? n0 : n0 - DFF;
        t = TrTile{p->in[22], (bf16_t*)(p->ws + WS_BT3), DFF2, 64 * kt, n0, 1024, (nn >> 7) * 256 + (n0 < DFF ? 0 : 128) + (nn & 127)}; }
    else if (idx < 3072) { idx -= 2304; const int kt = idx >> 4, nt = idx & 15; t = TrTile{p->in[25], (bf16_t*)(p->ws + WS_BT4), DM, 64 * kt, 64 * nt, DFF, 64 * nt}; }
    else { idx -= 3072; const int type = idx >> 4, rem = idx & 15; t = TrTile{(type ? p->in[14] : p->in[12]) + rem * 4096, (bf16_t*)(p->ws + WS_WG) + idx * 4096, 64, 0, 0, 64, 0}; }
    return t;
}

__device__ __forceinline__ void phase0(KP p, LAS unsigned char* lds, const int wave) {
    constexpr int NMOD = 192, NTR = 3104 / 4;
    const int tid = wave * 64 + lane_id();
    for (int it = blockIdx.x; it < NMOD + NTR; it += gridDim.x) {
        if (it < NMOD) { p0_mod_item(p, lds, it, wave); continue; }
        const int idx0 = (it - NMOD) * 4; LAS float* tile = (LAS float*)lds;
        f32x4 v[4][2];
        { const int r = tid >> 4, c4 = (tid & 15) * 4;
#pragma unroll
          for (int q = 0; q < 4; ++q) { const TrTile t = p0_tile_desc(p, idx0 + q);
#pragma unroll
              for (int ps = 0; ps < 2; ++ps) v[q][ps] = *(const f32x4*)(t.src + (size_t)(t.k0 + r + 32 * ps) * t.N + t.n0 + c4); }
#pragma unroll
          for (int q = 0; q < 4; ++q)
#pragma unroll
              for (int ps = 0; ps < 2; ++ps)
#pragma unroll
                  for (int j = 0; j < 4; ++j) tile[q * 4160 + (r + 32 * ps) * 65 + c4 + j] = v[q][ps][j]; }
        __syncthreads();
        { const int n = tid >> 3, kk = (tid & 7) * 8;
#pragma unroll
          for (int q = 0; q < 4; ++q) { const TrTile t = p0_tile_desc(p, idx0 + q); float x[8];
#pragma unroll
              for (int i = 0; i < 8; ++i) x[i] = tile[q * 4160 + (kk + i) * 65 + n];
              u32x4 w; w.x = cvt_pk_bf16(x[0], x[1]); w.y = cvt_pk_bf16(x[2], x[3]); w.z = cvt_pk_bf16(x[4], x[5]); w.w = cvt_pk_bf16(x[6], x[7]);
              *(u32x4*)(t.dst + (size_t)(t.drow0 + n) * t.Kd + t.k0 + kk) = w; } }
        __syncthreads();
    }
}

__device__ __forceinline__ void p1_rows(KP p, const float* mod, int row_begin, int nrows, const int lane) {
    f32x4 ns[4], sh[4]; int bcur = -1;
    for (int r = 0; r < nrows; r += 3) {
        f32x4 v[3][4];
#pragma unroll
        for (int q = 0; q < 3; ++q) { const int row = (r + q < nrows) ? row_begin + r + q : row_begin + r;
            const float* xr = row < NCTX ? p->in[0] + (size_t)row * DM : p->in[1] + (size_t)(row - NCTX) * DM;
#pragma unroll
            for (int i = 0; i < 4; ++i) v[q][i] = *(const f32x4*)(xr + 256 * i + 4 * lane); }
#pragma unroll
        for (int q = 0; q < 3; ++q) { if (r + q < nrows) { const int row = row_begin + r + q; const int b = bidx_of_row(row);
            if (b != bcur) { bcur = b;
#pragma unroll
                for (int i = 0; i < 4; ++i) { const int c = 256 * i + 4 * lane;
                    ns[i] = *(const f32x4*)(p->in[5] + c) * (*(const f32x4*)(mod + b * 6144 + 1024 + c) + 1.0f); sh[i] = *(const f32x4*)(mod + b * 6144 + c); } }
            float ss = 0.f;
#pragma unroll
            for (int i = 0; i < 4; ++i) ss += (v[q][i][0] * v[q][i][0] + v[q][i][1] * v[q][i][1]) + (v[q][i][2] * v[q][i][2] + v[q][i][3] * v[q][i][3]);
#pragma unroll
            for (int o = 1; o < 64; o <<= 1) ss += shfl_f(ss, lane ^ o);
            const float inv = __builtin_amdgcn_rsqf(ss * (1.0f / 1024.0f) + EPS);
            bf16_t* hp = (bf16_t*)(p->ws + WS_H1) + (size_t)row * DM;
#pragma unroll
            for (int i = 0; i < 4; ++i) { const f32x4 h = v[q][i] * inv * ns[i] + sh[i]; u32x2 w; w.x = cvt_pk_bf16(h[0], h[1]); w.y = cvt_pk_bf16(h[2], h[3]); *(u32x2*)(hp + 256 * i + 4 * lane) = w; } } }
    }
}
__device__ __forceinline__ void p1_shw(KP p, const float* mod, int r0, int nrows, const int lane) {
    float s2[5][16];
#pragma unroll
    for (int b = 0; b < 5; ++b)
#pragma unroll
        for (int i = 0; i < 2; ++i) { const f32x4 a = *(const f32x4*)(mod + b * 6144 + 3072 + 512 * i + 8 * lane), c = *(const f32x4*)(mod + b * 6144 + 3072 + 512 * i + 8 * lane + 4);
#pragma unroll
            for (int j = 0; j < 4; ++j) { s2[b][8 * i + j] = a[j]; s2[b][8 * i + 4 + j] = c[j]; } }
    const bf16_t* bt3 = (const bf16_t*)(p->ws + WS_BT3);
    float* shw = (float*)(p->ws + WS_SHW);
    for (int r = 0; r < nrows; ++r) { const int n = r0 + r; float wv[16];
#pragma unroll
        for (int i = 0; i < 2; ++i) { const u32x4 q = *(const u32x4*)(bt3 + (size_t)n * 1024 + 512 * i + 8 * lane);
            wv[8 * i + 0] = bflo(q.x); wv[8 * i + 1] = bfhi(q.x); wv[8 * i + 2] = bflo(q.y); wv[8 * i + 3] = bfhi(q.y); wv[8 * i + 4] = bflo(q.z); wv[8 * i + 5] = bfhi(q.z); wv[8 * i + 6] = bflo(q.w); wv[8 * i + 7] = bfhi(q.w); }
#pragma unroll
        for (int b = 0; b < 5; ++b) { float d = 0.f;
#pragma unroll
            for (int i = 0; i < 16; ++i) d += wv[i] * s2[b][i];
#pragma unroll
            for (int o = 1; o < 64; o <<= 1) d += shfl_f(d, lane ^ o);
            if (lane == 0) shw[b * 6144 + n] = d; } }
}
__device__ __forceinline__ void phase1(KP p, const int wave) {
    const int lane = lane_id();
    const float* mod = (const float*)(p->ws + WS_MOD);
    if (blockIdx.x == gridDim.x - 1) { float* sp = (float*)(p->ws + WS_SP8);
        for (int i = wave * 64 + lane; i < 1024; i += NTHREADS) sp[i] = -8.0f * log1pf(__expf(-p->in[16][i])); }
    const int nw = gridDim.x * 8, w = blockIdx.x * 8 + wave;
    { const int per = (NTOK + nw - 1) / nw; const int r0 = w * per; const int n = r0 >= NTOK ? 0 : (NTOK - r0 < per ? NTOK - r0 : per); p1_rows(p, mod, r0, n, lane); }
    { const int per = (DFF2 + nw - 1) / nw; const int r0 = w * per; const int n = r0 >= DFF2 ? 0 : (DFF2 - r0 < per ? DFF2 - r0 : per); p1_shw(p, mod, r0, n, lane); }
}

__device__ __forceinline__ int vt_off(int ch, int q) { const int sw = (ch & 15) ^ ((ch >> 3) & 15); return ch * 256 + ((((q >> 3) ^ sw) & 15) << 4) + ((q & 7) << 1); }

__device__ __forceinline__ void sgu_item(KP p, LAS unsigned char* lds, int item, const int wave) {
    const int lane = lane_id(), tid = wave * 64 + lane, fr = lane & 15, fq = lane >> 4;
    const int chunk = item >> 2, g = item & 3, t0 = chunk * 128;
    const bf16_t* Z = (const bf16_t*)(p->ws + WS_Z);
    {
        const int cg = tid & 15, qg = tid >> 4, ch0 = 8 * cg, q0 = 4 * qg;
        float v[4][8];
#pragma unroll
        for (int r = 0; r < 4; ++r) { const u32x4 w = *(const u32x4*)(Z + (size_t)(t0 + q0 + r) * DIN + 1536 + 128 * g + ch0);
            v[r][0] = geluf_(bflo(w.x)); v[r][1] = geluf_(bfhi(w.x)); v[r][2] = geluf_(bflo(w.y)); v[r][3] = geluf_(bfhi(w.y));
            v[r][4] = geluf_(bflo(w.z)); v[r][5] = geluf_(bfhi(w.z)); v[r][6] = geluf_(bflo(w.w)); v[r][7] = geluf_(bfhi(w.w)); }
#pragma unroll
        for (int i = 0; i < 8; ++i) { u32x2 w; w.x = cvt_pk_bf16(v[0][i], v[1][i]); w.y = cvt_pk_bf16(v[2][i], v[3][i]); *(LAS u32x2*)(lds + vt_off(ch0 + i, q0)) = w; }
    }
    unsigned short uv16[4][8]; float bsv4[4];
#pragma unroll
    for (int jj = 0; jj < 4; ++jj) { const int pp = 16 * wave + 4 * fq + jj; bsv4[jj] = p->in[18][g * 128 + pp];
#pragma unroll
        for (int nt = 0; nt < 8; ++nt) uv16[jj][nt] = Z[(size_t)(t0 + pp) * DIN + 1024 + 128 * g + 16 * nt + fr]; }
    const float* Ws = p->in[17] + (size_t)g * 16384;
    bf16x8 af[4];
#pragma unroll
    for (int kk = 0; kk < 4; ++kk) { const float* ap = Ws + (16 * wave + fr) * 128 + 32 * kk + 8 * fq; const f32x4 a0 = *(const f32x4*)ap, a1 = *(const f32x4*)(ap + 4);
        u32x4 w; w.x = cvt_pk_bf16(a0[0], a0[1]); w.y = cvt_pk_bf16(a0[2], a0[3]); w.z = cvt_pk_bf16(a1[0], a1[1]); w.w = cvt_pk_bf16(a1[2], a1[3]); af[kk] = __builtin_bit_cast(bf16x8, w); }
    __syncthreads();
    f32x4 acc[8];
#pragma unroll
    for (int nt = 0; nt < 8; ++nt) { acc[nt] = (f32x4){0.f, 0.f, 0.f, 0.f};
#pragma unroll
        for (int kk = 0; kk < 4; ++kk) { const bf16x8 bfr = *(const LAS bf16x8*)(lds + vt_off(16 * nt + fr, 32 * kk + 8 * fq));
            acc[nt] = __builtin_amdgcn_mfma_f32_16x16x32_bf16(af[kk], bfr, acc[nt], 0, 0, 0); } }
    bf16_t* osgu = (bf16_t*)(p->ws + WS_OSGU); float* sgp = (float*)(p->ws + WS_SGP);
    float ssq[4] = {0.f, 0.f, 0.f, 0.f};
#pragma unroll
    for (int jj = 0; jj < 4; ++jj) { const int pp = 16 * wave + 4 * fq + jj, tok = t0 + pp; const float bsv = bsv4[jj];
#pragma unroll
        for (int nt = 0; nt < 8; ++nt) { const int ch = 16 * nt + fr; const float uv = geluf_(bf2f(uv16[jj][nt]));
            const float o = uv * (acc[nt][jj] + bsv); osgu[(size_t)tok * 512 + 128 * g + ch] = (bf16_t)(cvt_pk_bf16(o, o) & 0xffffu); ssq[jj] += o * o; } }
#pragma unroll
    for (int jj = 0; jj < 4; ++jj) { float s = ssq[jj]; s += shfl_f(s, lane ^ 1); s += shfl_f(s, lane ^ 2); s += shfl_f(s, lane ^ 4); s += shfl_f(s, lane ^ 8);
        if (fr == 0) sgp[(size_t)(t0 + 16 * wave + 4 * fq + jj) * 4 + g] = s; }
    __syncthreads();
}

__device__ __forceinline__ unsigned pk_f16(float a, float b) { return __builtin_bit_cast(unsigned, __builtin_amdgcn_cvt_pkrtz(a, b)); }
typedef _Float16 h2_t __attribute__((ext_vector_type(2)));
__device__ __forceinline__ float f16lo(unsigned w) { return (float)__builtin_bit_cast(h2_t, w)[0]; }
__device__ __forceinline__ float f16hi(unsigned w) { return (float)__builtin_bit_cast(h2_t, w)[1]; }

__device__ __forceinline__ void lru_scan_item(KP p, LAS unsigned char* lds, int chunk, const int wave) {
    const int lane = lane_id(), fr = lane & 15, fq = lane >> 4;
    const int h = wave, t0 = chunk * 32;
    const bool ctx = t0 < NCTX;
    const int seq_start = ctx ? (t0 & ~255) : NCTX + ((t0 - NCTX) & ~2047);
    const int seq_end = seq_start + (ctx ? 256 : 2048);
    const bf16_t* Z = (const bf16_t*)(p->ws + WS_Z);
    LAS float* xc = (LAS float*)(lds + wave * 8704);
    {
        const int gc = h * 64 + lane;
        const float c0 = p->in[10][gc], c1 = p->in[10][512 + gc], c2 = p->in[10][1024 + gc], c3 = p->in[10][1536 + gc], cbv = p->in[11][gc];
        float xw[35];
#pragma unroll
        for (int i = 0; i < 35; ++i) { const int t = t0 - 2 + i; xw[i] = (t >= seq_start && t < seq_end) ? bf2f(Z[(size_t)t * DIN + gc]) : 0.f; }
#pragma unroll
        for (int tt = 0; tt < 32; ++tt) xc[tt * 68 + lane] = cbv + c0 * xw[tt] + c1 * xw[tt + 1] + c2 * xw[tt + 2] + c3 * xw[tt + 3];
    }
    bf16x8 af[2][2];
#pragma unroll
    for (int mt = 0; mt < 2; ++mt)
#pragma unroll
        for (int ks = 0; ks < 2; ++ks) { const LAS float* ap = xc + (16 * mt + fr) * 68 + 32 * ks + 8 * fq; const f32x4 a0 = *(const LAS f32x4*)ap, a1 = *(const LAS f32x4*)(ap + 4);
            u32x4 w; w.x = cvt_pk_bf16(a0[0], a0[1]); w.y = cvt_pk_bf16(a0[2], a0[3]); w.z = cvt_pk_bf16(a1[0], a1[1]); w.w = cvt_pk_bf16(a1[2], a1[3]); af[mt][ks] = __builtin_bit_cast(bf16x8, w); }
    const bf16_t* WG = (const bf16_t*)(p->ws + WS_WG);
    float* sumA = (float*)(p->ws + WS_SUMA); float* sumB = (float*)(p->ws + WS_SUMB);
    u32x2* HS = (u32x2*)(p->ws + WS_HS); u32x2* AC = (u32x2*)(p->ws + WS_AC);
    const size_t sbase = (size_t)(chunk * 8 + h) * 8 * 64 + lane;
    float hsum[2][4][4];
#pragma unroll
    for (int d = 0; d < 2; ++d) {
        bf16x8 wfr[4][4]; float bavv[4], bxvv[4], lamv[4];
#pragma unroll
        for (int nt = 0; nt < 4; ++nt) {
            const bf16_t* wa = WG + (size_t)((0 * 2 + d) * 8 + h) * 4096 + (16 * nt + fr) * 64 + 8 * fq;
            const bf16_t* wx = WG + (size_t)((1 * 2 + d) * 8 + h) * 4096 + (16 * nt + fr) * 64 + 8 * fq;
            wfr[nt][0] = *(const bf16x8*)wa; wfr[nt][1] = *(const bf16x8*)(wa + 32); wfr[nt][2] = *(const bf16x8*)wx; wfr[nt][3] = *(const bf16x8*)(wx + 32);
            const int gcw = h * 64 + 16 * nt + fr;
            bavv[nt] = p->in[13][d * 512 + gcw]; bxvv[nt] = p->in[15][d * 512 + gcw]; lamv[nt] = ((const float*)(p->ws + WS_SP8))[d * 512 + gcw];
        }
#pragma unroll
        for (int nt = 0; nt < 4; ++nt) {
            const int gc = h * 64 + 16 * nt + fr;
            float av[2][4], bv[2][4];
            {
                f32x4 ga[2], gx[2];
                const bf16x8 ba0 = wfr[nt][0], ba1 = wfr[nt][1], bx0 = wfr[nt][2], bx1 = wfr[nt][3];
#pragma unroll
                for (int mt = 0; mt < 2; ++mt) {
                    f32x4 z = (f32x4){0.f, 0.f, 0.f, 0.f};
                    z = __builtin_amdgcn_mfma_f32_16x16x32_bf16(af[mt][0], ba0, z, 0, 0, 0); ga[mt] = __builtin_amdgcn_mfma_f32_16x16x32_bf16(af[mt][1], ba1, z, 0, 0, 0);
                    z = (f32x4){0.f, 0.f, 0.f, 0.f};
                    z = __builtin_amdgcn_mfma_f32_16x16x32_bf16(af[mt][0], bx0, z, 0, 0, 0); gx[mt] = __builtin_amdgcn_mfma_f32_16x16x32_bf16(af[mt][1], bx1, z, 0, 0, 0);
                }
                const float bav = bavv[nt], bxv = bxvv[nt], lam = lamv[nt];
                const float sp8 = lam;
                constexpr float L2E = 1.44269504f;
                const f32x2 nb1 = (f32x2){-bav * L2E, -bav * L2E}, nb2 = (f32x2){-bxv * L2E, -bxv * L2E};
#pragma unroll
                for (int mt = 0; mt < 2; ++mt)
#pragma unroll
                    for (int hp = 0; hp < 2; ++hp) {
                        const f32x2 g = (f32x2){ga[mt][2 * hp], ga[mt][2 * hp + 1]}, xg = (f32x2){gx[mt][2 * hp], gx[mt][2 * hp + 1]};
                        const f32x2 t1 = g * (-L2E) + nb1, t2 = xg * (-L2E) + nb2;
                        const f32x2 d1 = (f32x2){__builtin_amdgcn_exp2f(t1.x), __builtin_amdgcn_exp2f(t1.y)} + 1.0f, d2 = (f32x2){__builtin_amdgcn_exp2f(t2.x), __builtin_amdgcn_exp2f(t2.y)} + 1.0f;
                        const f32x2 r = (f32x2){frcp(d1.x), frcp(d1.y)}, ig = (f32x2){frcp(d2.x), frcp(d2.y)};
                        const f32x2 la = r * sp8, l2 = la * L2E, x2 = la + la;
                        const f32x2 a = (f32x2){__builtin_amdgcn_exp2f(l2.x), __builtin_amdgcn_exp2f(l2.y)};
                        f32x2 pz = x2 * (1.0f / 720.0f) + (1.0f / 120.0f); pz = pz * x2 + (1.0f / 24.0f); pz = pz * x2 + (1.0f / 6.0f); pz = pz * x2 + 0.5f; pz = pz * x2 + 1.0f;
                        const f32x2 omt = -(x2 * pz), oma = 1.0f - a * a;
                        const f32x2 om = (f32x2){x2.x > -0.5f ? omt.x : oma.x, x2.y > -0.5f ? omt.y : oma.y};
                        const f32x2 xd = (f32x2){xc[(16 * mt + 4 * fq + 2 * hp) * 68 + 16 * nt + fr], xc[(16 * mt + 4 * fq + 2 * hp + 1) * 68 + 16 * nt + fr]};
                        const f32x2 bb = (f32x2){__builtin_amdgcn_sqrtf(om.x), __builtin_amdgcn_sqrtf(om.y)} * (ig * xd);
                        av[mt][2 * hp] = a.x; av[mt][2 * hp + 1] = a.y; bv[mt][2 * hp] = bb.x; bv[mt][2 * hp + 1] = bb.y;
                    }
            }
            float hin = 0.f, acar = 1.f;
#pragma unroll
            for (int mi = 0; mi < 2; ++mi) {
                const int mt = d == 0 ? mi : 1 - mi;
                float a0, a1, a2, a3, b0, b1, b2, b3;
                if (d == 0) { a0 = av[mt][0]; a1 = av[mt][1]; a2 = av[mt][2]; a3 = av[mt][3]; b0 = bv[mt][0]; b1 = bv[mt][1]; b2 = bv[mt][2]; b3 = bv[mt][3]; }
                else { a0 = av[mt][3]; a1 = av[mt][2]; a2 = av[mt][1]; a3 = av[mt][0]; b0 = bv[mt][3]; b1 = bv[mt][2]; b2 = bv[mt][1]; b3 = bv[mt][0]; }
                const float Al = (a0 * a1) * (a2 * a3), Bl = ((b0 * a1 + b1) * a2 + b2) * a3 + b3;
                float hh = hin, Ap = acar, At = 1.f;
#pragma unroll
                for (int k = 0; k < 4; ++k) { const int kq = d == 0 ? k : 3 - k;
                    const float Ak = shfl_f(Al, fr + 16 * kq), Bk = shfl_f(Bl, fr + 16 * kq);
                    const bool before = d == 0 ? (kq < fq) : (kq > fq);
                    if (before) { hh = Ak * hh + Bk; Ap *= Ak; }
                    At *= Ak; }
                const float h0 = a0 * hh + b0, h1 = a1 * h0 + b1, h2 = a2 * h1 + b2, h3 = a3 * h2 + b3;
                const float c0 = Ap * a0, c1 = c0 * a1, c2 = c1 * a2, c3 = c2 * a3;
                u32x2 cw;
                if (d == 0) { hsum[mt][nt][0] = h0; hsum[mt][nt][1] = h1; hsum[mt][nt][2] = h2; hsum[mt][nt][3] = h3; cw.x = pk_f16(c0, c1); cw.y = pk_f16(c2, c3); }
                else { hsum[mt][nt][3] += h0; hsum[mt][nt][2] += h1; hsum[mt][nt][1] += h2; hsum[mt][nt][0] += h3; cw.x = pk_f16(c3, c2); cw.y = pk_f16(c1, c0); }
                AC[(size_t)d * (384 * 8 * 8 * 64) + sbase + (mt * 4 + nt) * 64] = cw;
                hin = shfl_f(h3, fr + (d == 0 ? 48 : 0));
                acar *= At;
            }
            if (fq == 0) { sumA[(size_t)(d * 384 + chunk) * 512 + gc] = acar; sumB[(size_t)(d * 384 + chunk) * 512 + gc] = hin; }
        }
    }
#pragma unroll
    for (int mt = 0; mt < 2; ++mt)
#pragma unroll
        for (int nt = 0; nt < 4; ++nt) { u32x2 hw; hw.x = cvt_pk_bf16(hsum[mt][nt][0], hsum[mt][nt][1]); hw.y = cvt_pk_bf16(hsum[mt][nt][2], hsum[mt][nt][3]); HS[sbase + (mt * 4 + nt) * 64] = hw; }
}

__device__ __forceinline__ void lru_fix_item(KP p, LAS unsigned char* lds, int chunk, const int wave) {
    const int lane = lane_id(), fr = lane & 15, fq = lane >> 4;
    const int h = wave, t0 = chunk * 32;
    const bool ctx = t0 < NCTX;
    const int seq_start = ctx ? (t0 & ~255) : NCTX + ((t0 - NCTX) & ~2047);
    const int seq_end = seq_start + (ctx ? 256 : 2048);
    const bf16_t* Z = (const bf16_t*)(p->ws + WS_Z);
    LAS float* sx = (LAS float*)lds;
    const float* sumA = (const float*)(p->ws + WS_SUMA); const float* sumB = (const float*)(p->ws + WS_SUMB);
    const u32x2* HS = (const u32x2*)(p->ws + WS_HS); const u32x2* AC = (const u32x2*)(p->ws + WS_AC);
    const size_t sbase = (size_t)(chunk * 8 + h) * 8 * 64 + lane;
    f32x4 hs[2][4]; u32x2 hsw[2][4], acf[2][4], acb[2][4]; unsigned short yv[2][4][4];
#pragma unroll
    for (int mt = 0; mt < 2; ++mt)
#pragma unroll
        for (int nt = 0; nt < 4; ++nt) { hsw[mt][nt] = HS[sbase + (mt * 4 + nt) * 64]; acf[mt][nt] = AC[sbase + (mt * 4 + nt) * 64]; acb[mt][nt] = AC[(size_t)(384 * 8 * 8 * 64) + sbase + (mt * 4 + nt) * 64];
#pragma unroll
            for (int jj = 0; jj < 4; ++jj) yv[mt][nt][jj] = Z[(size_t)(t0 + 16 * mt + 4 * fq + jj) * DIN + 512 + h * 64 + 16 * nt + fr]; }
    float car[2];
    const int gcl = h * 64 + lane;
#pragma unroll
    for (int d = 0; d < 2; ++d) {
        float hcar = 0.f;
        if (!ctx) hcar = p->in[2][(size_t)((t0 - NCTX) >> 11) * 1024 + d * 512 + gcl];
        const int step = d == 0 ? 1 : -1;
        int c = d == 0 ? (seq_start >> 5) : (seq_end >> 5) - 1;
        int n = d == 0 ? chunk - c : c - chunk;
        const float* sa = sumA + (size_t)d * 384 * 512 + gcl; const float* sb = sumB + (size_t)d * 384 * 512 + gcl;
        for (; n > 0; n -= 16, c += 16 * step) {
            float a8[16], b8[16];
#pragma unroll
            for (int i = 0; i < 16; ++i) { const bool v = i < n; const int cc = v ? c + i * step : c; const float la = sa[(size_t)cc * 512], lb = sb[(size_t)cc * 512]; a8[i] = v ? la : 1.f; b8[i] = v ? lb : 0.f; }
#pragma unroll
            for (int i = 0; i < 16; ++i) hcar = a8[i] * hcar + b8[i];
        }
        car[d] = hcar;
        if (ctx) {
            if (d == 0 && t0 + 32 == seq_end) p->out[(size_t)NTOK * DM + (size_t)(t0 >> 8) * 1024 + gcl] = sa[(size_t)chunk * 512] * hcar + sb[(size_t)chunk * 512];
            if (d == 1 && t0 == seq_start) p->out[(size_t)NTOK * DM + (size_t)(t0 >> 8) * 1024 + 512 + gcl] = sa[(size_t)chunk * 512] * hcar + sb[(size_t)chunk * 512];
        }
    }
    float ov[2][4][4];
#pragma unroll
    for (int nt = 0; nt < 4; ++nt) { const float cf = shfl_f(car[0], 16 * nt + fr), cbk = shfl_f(car[1], 16 * nt + fr);
#pragma unroll
        for (int mt = 0; mt < 2; ++mt) { hs[mt][nt] = (f32x4){bflo(hsw[mt][nt].x), bfhi(hsw[mt][nt].x), bflo(hsw[mt][nt].y), bfhi(hsw[mt][nt].y)};
            const float af0 = f16lo(acf[mt][nt].x), af1 = f16hi(acf[mt][nt].x), af2 = f16lo(acf[mt][nt].y), af3 = f16hi(acf[mt][nt].y);
            const float ab0 = f16lo(acb[mt][nt].x), ab1 = f16hi(acb[mt][nt].x), ab2 = f16lo(acb[mt][nt].y), ab3 = f16hi(acb[mt][nt].y);
            ov[mt][nt][0] = geluf_(bf2f(yv[mt][nt][0])) * (hs[mt][nt][0] + af0 * cf + ab0 * cbk);
            ov[mt][nt][1] = geluf_(bf2f(yv[mt][nt][1])) * (hs[mt][nt][1] + af1 * cf + ab1 * cbk);
            ov[mt][nt][2] = geluf_(bf2f(yv[mt][nt][2])) * (hs[mt][nt][2] + af2 * cf + ab2 * cbk);
            ov[mt][nt][3] = geluf_(bf2f(yv[mt][nt][3])) * (hs[mt][nt][3] + af3 * cf + ab3 * cbk); } }
#pragma unroll
    for (int mt = 0; mt < 2; ++mt)
#pragma unroll
        for (int jj = 0; jj < 4; ++jj) { float s = 0.f;
#pragma unroll
            for (int nt = 0; nt < 4; ++nt) s += ov[mt][nt][jj] * ov[mt][nt][jj];
            s += shfl_f(s, lane ^ 1); s += shfl_f(s, lane ^ 2); s += shfl_f(s, lane ^ 4); s += shfl_f(s, lane ^ 8);
            if (fr == 0) sx[(16 * mt + 4 * fq + jj) * 8 + wave] = s; }
    __syncthreads();
    bf16_t* ob = (bf16_t*)(p->ws + WS_H1);
    float gl[4];
#pragma unroll
    for (int nt = 0; nt < 4; ++nt) gl[nt] = p->in[19][h * 64 + 16 * nt + fr];
#pragma unroll
    for (int mt = 0; mt < 2; ++mt)
#pragma unroll
        for (int jj = 0; jj < 4; ++jj) { const int tl = 16 * mt + 4 * fq + jj; const f32x4 s0 = *(const LAS f32x4*)(sx + tl * 8), s1 = *(const LAS f32x4*)(sx + tl * 8 + 4);
            const float tot = ((s0[0] + s0[1]) + (s0[2] + s0[3])) + ((s1[0] + s1[1]) + (s1[2] + s1[3]));
            const float inv = __builtin_amdgcn_rsqf(tot * (1.0f / 512.0f) + EPS);
#pragma unroll
            for (int nt = 0; nt < 4; ++nt) { const float o = ov[mt][nt][jj] * inv * gl[nt]; const unsigned w = cvt_pk_bf16(o, o);
                ob[(size_t)(t0 + tl) * DM + h * 64 + 16 * nt + fr] = (bf16_t)(w & 0xffffu); } }
    __syncthreads();
}

__device__ __forceinline__ void phase2(KP p, LAS unsigned char* lds, const int wave) {
    constexpr int NSGU = 384, NLRU = 384;
    const int b = blockIdx.x, G = gridDim.x;
    if (G == 256) {
        lru_scan_item(p, lds, b, wave);
        if (b < 128) lru_scan_item(p, lds, 256 + b, wave);
        else { __syncthreads(); for (int i = 0; i < 3; ++i) sgu_item(p, lds, 3 * (b - 128) + i, wave); }
    } else {
        for (int it = b; it < NSGU + NLRU; it += G) { __syncthreads(); if (it < NLRU) lru_scan_item(p, lds, it, wave); else sgu_item(p, lds, it - NLRU, wave); }
    }
}

__device__ __forceinline__ void sgu_norm_item(KP p, int item, const int wave, const int lane) {
    const int row0 = item * 32 + wave * 4;
    const bf16_t* osgu = (const bf16_t*)(p->ws + WS_OSGU); const float* sgp = (const float*)(p->ws + WS_SGP); bf16_t* ob = (bf16_t*)(p->ws + WS_H1);
    const f32x4 g0 = *(const f32x4*)(p->in[20] + 8 * lane), g1 = *(const f32x4*)(p->in[20] + 8 * lane + 4);
#pragma unroll
    for (int r = 0; r < 4; ++r) { const int row = row0 + r; const f32x4 s = *(const f32x4*)(sgp + (size_t)row * 4);
        const float inv = __builtin_amdgcn_rsqf(((s[0] + s[1]) + (s[2] + s[3])) * (1.0f / 512.0f) + EPS);
        const u32x4 ow = *(const u32x4*)(osgu + (size_t)row * 512 + 8 * lane);
        const f32x4 a = (f32x4){bflo(ow.x), bfhi(ow.x), bflo(ow.y), bfhi(ow.y)} * inv * g0, c = (f32x4){bflo(ow.z), bfhi(ow.z), bflo(ow.w), bfhi(ow.w)} * inv * g1;
        u32x4 w; w.x = cvt_pk_bf16(a[0], a[1]); w.y = cvt_pk_bf16(a[2], a[3]); w.z = cvt_pk_bf16(c[0], c[1]); w.w = cvt_pk_bf16(c[2], c[3]);
        *(u32x4*)(ob + (size_t)row * DM + 512 + 8 * lane) = w; }
}

__device__ __forceinline__ void phase3(KP p, LAS unsigned char* lds, const int wave) {
    const int lane = lane_id();
    constexpr int NLRU = 384, NNRM = 384;
    const int b = blockIdx.x, G = gridDim.x;
    if (G == 256) {
        if (b >= 128) for (int i = 0; i < 3; ++i) sgu_norm_item(p, 3 * (b - 128) + i, wave, lane);
        lru_fix_item(p, lds, b, wave);
        if (b < 128) lru_fix_item(p, lds, 256 + b, wave);
    } else {
        for (int it = b; it < NLRU + NNRM; it += G) { if (it < NLRU) lru_fix_item(p, lds, it, wave); else sgu_norm_item(p, it - NLRU, wave, lane); }
    }
}

__device__ __forceinline__ void phase7(KP p, const int wave) {
    const int lane = lane_id();
    const float* ssq4 = (const float*)(p->ws + WS_SSQ4);
    f32x4 fn[4];
#pragma unroll
    for (int i = 0; i < 4; ++i) fn[i] = *(const f32x4*)(p->in[26] + 256 * i + 4 * lane);
    for (int it = blockIdx.x; it < NTOK / 32; it += gridDim.x) {
#pragma unroll
        for (int r = 0; r < 4; ++r) { const int row = it * 32 + wave * 4 + r; const float* sp = ssq4 + (size_t)row * 16;
            const f32x4 s0 = *(const f32x4*)sp, s1 = *(const f32x4*)(sp + 4), s2 = *(const f32x4*)(sp + 8), s3 = *(const f32x4*)(sp + 12);
            const f32x4 st = (s0 + s1) + (s2 + s3);
            const float inv = __builtin_amdgcn_rsqf(((st[0] + st[1]) + (st[2] + st[3])) * (1.0f / 1024.0f) + EPS);
            float* op = p->out + (size_t)row * DM;
#pragma unroll
            for (int i = 0; i < 4; ++i) { const f32x4 v = *(const f32x4*)(op + 256 * i + 4 * lane); *(f32x4*)(op + 256 * i + 4 * lane) = v * inv * fn[i]; } }
    }
}

#define XB_TMO      128
#define XB_XCNT(j)  (256  + 64 * (j))
#define XB_XSUB(j)  (1280 + 64 * (j))
#define XB_XGEN(j)  (2304 + 64 * (j))
#define XB_TOP      3328
#define XB_TOPGEN   3392
#define XCD_BAR_WORDS 3456
#define XB_SPIN_CAP (1u << 18)
__device__ __forceinline__ unsigned xb_ld(unsigned* p)              { return __hip_atomic_load(p, __ATOMIC_RELAXED, __HIP_MEMORY_SCOPE_AGENT); }
__device__ __forceinline__ unsigned xb_add(unsigned* p, unsigned v) { return __hip_atomic_fetch_add(p, v, __ATOMIC_RELAXED, __HIP_MEMORY_SCOPE_AGENT); }
__device__ __forceinline__ unsigned xb_xcc_id() { return (unsigned)__builtin_amdgcn_s_getreg((3 << 11) | 20) & 0xFu; }
#define XB_SPIN(cond, bar) do { unsigned _sp = 0; while (cond) { __builtin_amdgcn_s_sleep(1); \
    if ((++_sp & 255u) == 0u) { if (xb_ld(&(bar)[XB_TMO])) break; if (_sp > XB_SPIN_CAP) { atomicAdd(&(bar)[XB_TMO], 1u); break; } } } } while (0)
__device__ __forceinline__ void xcd_barrier_complete(unsigned* bar, unsigned x, unsigned& nloc, unsigned& nx) {
    const unsigned G = gridDim.x;
    unsigned sum, cnt, mine, sp = 0u;
    for (;;) {
        sum = 0u; cnt = 0u; mine = 0u;
#pragma unroll
        for (unsigned j = 0; j < 16; ++j) { const unsigned c = xb_ld(&bar[XB_XCNT(j)]); sum += c; cnt += (c > 0u) ? 1u : 0u; mine = (j == x) ? c : mine; }
        if (sum == G) break;
        __builtin_amdgcn_s_sleep(1);
        if ((++sp & 255u) == 0u) { if (xb_ld(&bar[XB_TMO])) break; if (sp > XB_SPIN_CAP) { atomicAdd(&bar[XB_TMO], 1u); break; } }
    }
    nloc = mine > 0u ? mine : 1u; nx = cnt > 0u ? cnt : 1u;
}
__device__ __forceinline__ void xcd_barrier(unsigned* bar, const unsigned x, volatile LAS unsigned* st, const bool leader) {
    asm volatile("s_waitcnt vmcnt(0)" ::: "memory");
    __syncthreads();
    if (leader) {
        __builtin_amdgcn_s_waitcnt(0);
        unsigned nloc = st[0], nx = st[1];
        if (nloc == 0u) { xcd_barrier_complete(bar, x, nloc, nx); st[0] = nloc; st[1] = nx; }
        const unsigned old = xb_add(&bar[XB_XSUB(x)], 1u);
        const unsigned gen = old / nloc;
        if (old + 1u == (gen + 1u) * nloc) {
            __builtin_amdgcn_fence(__ATOMIC_RELEASE, "agent");
            asm volatile("s_waitcnt vmcnt(0)" ::: "memory");
            const unsigned og = xb_add(&bar[XB_TOP], 1u);
            const unsigned tg = og / nx;
            if (og + 1u == (tg + 1u) * nx) xb_add(&bar[XB_TOPGEN], 1u);
            else XB_SPIN(xb_ld(&bar[XB_TOPGEN]) == tg, bar);
            __builtin_amdgcn_fence(__ATOMIC_ACQUIRE, "agent");
            xb_add(&bar[XB_XGEN(x)], 1u);
            asm volatile("s_waitcnt vmcnt(0)" ::: "memory");
        } else {
            XB_SPIN(xb_ld(&bar[XB_XGEN(x)]) == gen, bar);
            __builtin_amdgcn_fence(__ATOMIC_ACQUIRE, "agent");
            asm volatile("s_waitcnt vmcnt(0)" ::: "memory");
        }
    }
    __syncthreads();
}

__global__ void __launch_bounds__(NTHREADS, 2) fwd_kernel(P p_unused) {
    extern __shared__ __attribute__((aligned(16))) unsigned char lds_raw[];
    LAS unsigned char* lds = (LAS unsigned char*)lds_raw;
    cg::grid_group grid = cg::this_grid();
    int lo, hi; { KP q = kargs(); lo = q->ph_lo; hi = q->ph_hi; }
    const int G = gridDim.x, bx = blockIdx.x;
    const int wave = __builtin_amdgcn_readfirstlane(threadIdx.x >> 6);
#ifndef REPMASK
#define REPMASK 0
#endif
#define REPS(k) (((REPMASK >> (k)) & 1) ? 2 : 1)
#define IN(k) (lo <= (k) && (k) < hi)
    if (lo < 0) grid.sync();
    unsigned* bar; { KP q = kargs(); bar = (unsigned*)(q->ws + WS_BAR); }
    volatile LAS unsigned* bst = (volatile LAS unsigned*)(lds + EX_OFF + 8192);
    const bool leader = (wave == 0) && (lane_id() == 0);
    const unsigned xcc = xb_xcc_id();
    if (leader) { bst[0] = 0u; bst[1] = 0u; if (lo + 1 < hi) (void)xb_add(&bar[XB_XCNT(xcc)], 1u); }
    __syncthreads();
#define SEAM(k) do { if (IN(k) && IN((k) + 1)) xcd_barrier(bar, xcc, bst, leader); } while (0)
    if (IN(0)) for (int rep_ = 0; rep_ < REPS(0); ++rep_) { KP p = kargs(); phase0(p, lds, wave); }
    SEAM(0);
    if (IN(1)) for (int rep_ = 0; rep_ < REPS(1); ++rep_) { KP p = kargs(); phase1(p, wave); }
    SEAM(1);
    if (IN(2)) for (int rep_ = 0; rep_ < REPS(2); ++rep_) { KP p = kargs(); pg8::Gemm g{(const bf16_t*)(p->ws + WS_H1), (const bf16_t*)(p->ws + WS_BT1), NTOK, DIN, DM}; pg8::StaticOrder S; S.init(NTOK, DIN, G, bx, 192);
        EpiZ<3> E{(bf16_t*)(p->ws + WS_Z)}; pg8::gemm_phase<EpiZ<3>, 3>(lds, g, S, E, wave); }
    SEAM(2);
    if (IN(3)) for (int rep_ = 0; rep_ < REPS(3); ++rep_) { KP p = kargs(); phase2(p, lds, wave); }
    SEAM(3);
    if (IN(4)) for (int rep_ = 0; rep_ < REPS(4); ++rep_) { KP p = kargs(); phase3(p, lds, wave); }
    SEAM(4);
    if (IN(5)) for (int rep_ = 0; rep_ < REPS(5); ++rep_) { KP p = kargs(); pg8::Gemm g{(const bf16_t*)(p->ws + WS_H1), (const bf16_t*)(p->ws + WS_BT2), NTOK, DM, DM}; pg8::StaticOrder S; S.init(NTOK, DM, G, bx, 192);
        EpiG2<3> E{p->in[0], p->in[1], (const float*)(p->ws + WS_MOD), p->in[6], (float*)(p->ws + WS_X1), (bf16_t*)(p->ws + WS_H2), (float*)(p->ws + WS_SSQ2)}; pg8::gemm_phase<EpiG2<3>, 3>(lds, g, S, E, wave); }
    SEAM(5);
    if (IN(6)) for (int rep_ = 0; rep_ < REPS(6); ++rep_) { KP p = kargs(); pg8::Gemm g{(const bf16_t*)(p->ws + WS_H2), (const bf16_t*)(p->ws + WS_BT3), NTOK, DFF2, DM}; pg8::StaticOrder S; S.init(NTOK, DFF2, G, bx);
        EpiG3 E{(const float*)(p->ws + WS_SSQ2), (const float*)(p->ws + WS_SHW), p->in[23], p->in[24], (bf16_t*)(p->ws + WS_ACT), (LAS float*)(lds + EX_OFF)}; pg8::gemm_phase<EpiG3>(lds, g, S, E, wave); }
    SEAM(6);
    if (IN(7)) for (int rep_ = 0; rep_ < REPS(7); ++rep_) { KP p = kargs(); pg8::Gemm g{(const bf16_t*)(p->ws + WS_ACT), (const bf16_t*)(p->ws + WS_BT4), NTOK, DM, DFF}; pg8::StaticOrder S; S.init(NTOK, DM, G, bx, 192);
        EpiG4<3> E{(const float*)(p->ws + WS_MOD), (const float*)(p->ws + WS_X1), p->in[26], p->out, (unsigned*)(p->ws + WS_SGP), (unsigned*)(p->ws + WS_BAR + 16384)}; pg8::gemm_phase<EpiG4<3>, 3>(lds, g, S, E, wave); }
#undef IN
#undef SEAM
}

extern "C" void kernel_launch(void* const* d_in, const int* in_sizes, int n_in, void* d_out, int out_size, void* d_ws, size_t ws_size, hipStream_t stream) {
    static int grid = 0;
    if (grid == 0) {
        int dev = 0, cus = 0, per_cu = 0;
        hipGetDevice(&dev);
        hipDeviceGetAttribute(&cus, hipDeviceAttributeMultiprocessorCount, dev);
        hipFuncSetAttribute((const void*)fwd_kernel, hipFuncAttributeMaxDynamicSharedMemorySize, LDS_BYTES);
        hipOccupancyMaxActiveBlocksPerMultiprocessor(&per_cu, (const void*)fwd_kernel, NTHREADS, LDS_BYTES);
        if (per_cu < 1) { fprintf(stderr, "occupancy query says %d blocks per CU\n", per_cu); per_cu = 1; }
        grid = cus * per_cu;
        if (ws_size < WS_END) fprintf(stderr, "workspace too small: %zu < %zu\n", ws_size, (size_t)WS_END);
    }
    P p{};
    for (int i = 0; i < 27; ++i) p.in[i] = (const float*)d_in[i];
    p.out = (float*)d_out; p.ws = (unsigned char*)d_ws;
#if ONE_LAUNCH
    (void)hipMemsetAsync((char*)d_ws + WS_BAR, 0, 16384 + 64 * 256, stream);
    p.ph_lo = 0; p.ph_hi = 8;
    void* args[] = {&p};
    hipError_t e = hipLaunchCooperativeKernel((const void*)fwd_kernel, dim3(grid), dim3(NTHREADS), args, LDS_BYTES, stream);
    if (e != hipSuccess) fprintf(stderr, "cooperative launch failed: %s (grid %d)\n", hipGetErrorString(e), grid);
#else
    for (int k = 0; k < 8; ++k) { p.ph_lo = k; p.ph_hi = k + 1; hipLaunchKernelGGL(fwd_kernel, dim3(grid), dim3(NTHREADS), LDS_BYTES, stream, p); }
#endif
}
```

```cpp
#include <hip/hip_runtime.h>
#include <hip/hip_cooperative_groups.h>
#include <cstdio>
namespace cg = cooperative_groups;

#ifndef ONE_LAUNCH
#define ONE_LAUNCH 1
#endif

#define LAS __attribute__((address_space(3)))
typedef unsigned short bf16_t;
typedef short bf16x8 __attribute__((ext_vector_type(8)));
typedef float f32x4 __attribute__((ext_vector_type(4)));
typedef float f32x2 __attribute__((ext_vector_type(2)));
typedef unsigned u32x4 __attribute__((ext_vector_type(4)));
typedef unsigned u32x2 __attribute__((ext_vector_type(2)));

constexpr int DM = 1024, NTOK = 12288, NCTX = 4096, DIN = 2048, DFF = 3072, DFF2 = 6144;
constexpr float EPS = 1e-6f;
constexpr int NTHREADS = 512;
constexpr int LDS_BYTES = 131072 + 16384;
constexpr int EX_OFF = 131072;

constexpr size_t WS_BT1 = 0;
constexpr size_t WS_BT2 = 4194304;
constexpr size_t WS_BT3 = 6291456;
constexpr size_t WS_BT4 = 18874368;
constexpr size_t WS_WG = 25165824;
constexpr size_t WS_MOD = 25427968;
constexpr size_t WS_SHW = 25550848;
constexpr size_t WS_SUMA = 25673728;
constexpr size_t WS_SUMB = 27246592;
constexpr size_t WS_SGP = 28819456;
constexpr size_t WS_SSQ2 = 29016064;
constexpr size_t WS_SSQ4 = 29802496;
constexpr size_t WS_BAR = 30588928;
constexpr size_t WS_SP8 = WS_BAR + 65536;
constexpr size_t WS_H1 = 33554432;
constexpr size_t WS_H2 = 58720256;
constexpr size_t WS_Z = 83886080;
constexpr size_t WS_OSGU = 134217728;
constexpr size_t WS_ACT = WS_Z;
constexpr size_t WS_X1 = 167772160;
constexpr size_t WS_HS = WS_X1;
constexpr size_t WS_AC = WS_X1 + 25165824;
constexpr size_t WS_END = WS_X1 + 50331648;

struct P { const float* in[27]; float* out; unsigned char* ws; int ph_lo, ph_hi; };
typedef const __attribute__((address_space(4))) P* KP;
__device__ __forceinline__ KP kargs() { KP kp = (KP)__builtin_amdgcn_kernarg_segment_ptr(); asm volatile("" : "+s"(kp)); return kp; }

__device__ __forceinline__ unsigned cvt_pk_bf16(float lo, float hi) { unsigned r; asm volatile("v_cvt_pk_bf16_f32 %0, %1, %2" : "=v"(r) : "v"(lo), "v"(hi)); return r; }
__device__ __forceinline__ float bf2f(unsigned short h) { return __uint_as_float(((unsigned)h) << 16); }
__device__ __forceinline__ float bflo(unsigned w) { return __uint_as_float(w << 16); }
__device__ __forceinline__ float bfhi(unsigned w) { return __uint_as_float(w & 0xffff0000u); }
__device__ __forceinline__ float frcp(float x) { return __builtin_amdgcn_rcpf(x); }
__device__ __forceinline__ float sigmoidf_(float x) { return frcp(1.0f + __expf(-x)); }
__device__ __forceinline__ float siluf_(float x) { return x * frcp(1.0f + __expf(-x)); }
__device__ __forceinline__ float geluf_(float x) { const float u = 1.5957691216f * (x + 0.044715f * x * x * x); return x * frcp(1.0f + __expf(-u)); }
__device__ __forceinline__ float shfl_f(float v, int srclane) { return __int_as_float(__builtin_amdgcn_ds_bpermute(srclane << 2, __float_as_int(v))); }
template <int CTRL> __device__ __forceinline__ float dpp_f(float old, float src) { return __int_as_float(__builtin_amdgcn_update_dpp(__float_as_int(old), __float_as_int(src), CTRL, 0xf, 0xf, false)); }
__device__ __forceinline__ int lane_id() { int l; asm volatile("v_mbcnt_lo_u32_b32 %0, -1, 0\n\tv_mbcnt_hi_u32_b32 %0, -1, %0" : "=v"(l)); return l; }
__device__ __forceinline__ int bidx_of_row(int t) { return t < NCTX ? 0 : 1 + ((t - NCTX) >> 11); }

namespace pg8 {
constexpr int BM = 256, BK = 64, HALF = 128, HTB = HALF * BK * 2, STAGE_BYTES = 8 * HTB, NXCD = 8, WGM = 8;
__host__ __device__ __forceinline__ int lds_byte(int r, int c) { const int st = (r >> 4) * 2 + (c >> 5), rr = r & 15, cc = c & 31, ob = rr * 64 + cc * 2; return st * 1024 + (ob ^ (((ob >> 9) & 1) << 5)); }
__host__ __device__ __forceinline__ void stage_rc(int b, int& R, int& C) { const int st = b / 1024, sb = b % 1024, swz = sb ^ (((sb >> 9) & 1) << 5); R = (st >> 1) * 16 + swz / 64; C = (st & 1) * 32 + (swz % 64) / 2; }
__host__ __device__ __forceinline__ int perm32(int rho) { const int n = rho >> 4, i = rho & 15; return 8 * (i >> 2) + 4 * n + (i & 3); }
struct Unit { int pm, pn; };
struct Gemm { const bf16_t* A; const bf16_t* Bt; int M, N, K; };
struct StaticOrder {
    int nM, nN, nwg, G, c;
    __device__ void init(int M, int N, int G_, int c_, int RM = BM) { nM = M / RM; nN = N / BM; nwg = nM * nN; G = G_; c = c_; }
    __device__ bool next(int i, Unit& u) const {
        const long L = (long)i * G + c; if (L >= nwg) return false;
        int wgid = (int)L; { const int q = nwg / NXCD, r = nwg % NXCD, xcd = wgid % NXCD, off = wgid / NXCD; wgid = (xcd < r ? xcd * (q + 1) : r * (q + 1) + (xcd - r) * q) + off; }
        const int nig = WGM * nN, gid = wgid / nig, fm = gid * WGM, gsz = (nM - fm) < WGM ? (nM - fm) : WGM;
        u.pm = fm + ((wgid % nig) % gsz); u.pn = (wgid % nig) / gsz; return true;
    }
};

template <class Epi, int MB = 4>
__device__ __forceinline__ void gemm_phase(LAS unsigned char* lds, const Gemm g, const StaticOrder& S, const Epi& E, const int wave_) {
    const int wid = wave_, lane = lane_id(), tid = wid * 64 + lane, wr = wid >> 2, wc = wid & 3, fr = lane & 15, fq = lane >> 4;
    const int K = g.K, nt = K / BK;
    unsigned voffA[2], voffB[2];
#pragma unroll
    for (int i = 0; i < 2; ++i) { int R, C; stage_rc(tid * 16 + i * 8192, R, C); const int Rb = Epi::PERM ? ((R & ~31) + perm32(R & 31)) : R;
        voffA[i] = (unsigned)(R * K + C) * 2u; voffB[i] = (unsigned)(Rb * K + C) * 2u; }
    const size_t kstep = (size_t)(BK * 2);
    const size_t hstep = (size_t)HALF * K * 2;
    const size_t tstep = 2 * hstep;
    const size_t hstepA = (size_t)(32 * MB) * K * 2, tstepA = 2 * hstepA;
    const unsigned ldsw = (unsigned)wid * 1024u;
    const int aoff = lds_byte(wr * 16 * MB + fr, fq * 8), boff = lds_byte(wc * 32 + fr, fq * 8);
#define PG8_SA(b, h) (((b) * 2 + (h)) * HTB)
#define PG8_SB(b, h) ((4 + (b) * 2 + (h)) * HTB)
#define PG8_STAGE(bufoff, gbase, voff) do { _Pragma("unroll") for (int _i = 0; _i < 2; ++_i) \
        __builtin_amdgcn_global_load_lds((const unsigned*)((const char*)(gbase) + (voff)[_i]), (LAS unsigned*)(lds + (bufoff) + ldsw + _i * 8192), 16, 0, 0); } while (0)
#define PG8_LDA(dst, b, h) do { _Pragma("unroll") for (int m = 0; m < MB; ++m) _Pragma("unroll") for (int k = 0; k < 2; ++k) dst[m][k] = *(const LAS bf16x8*)(lds + PG8_SA(b, h) + aoff + m * 2048 + k * 1024); } while (0)
#define PG8_LDB(dst, b, h) do { _Pragma("unroll") for (int n = 0; n < 2; ++n) _Pragma("unroll") for (int k = 0; k < 2; ++k) dst[n][k] = *(const LAS bf16x8*)(lds + PG8_SB(b, h) + boff + n * 2048 + k * 1024); } while (0)
#define PG8_MMA(ai, bj, At, Bt) do { __builtin_amdgcn_s_setprio(1); _Pragma("unroll") for (int m = 0; m < MB; ++m) _Pragma("unroll") for (int n = 0; n < 2; ++n) _Pragma("unroll") for (int k = 0; k < 2; ++k) \
        acc[ai][bj][m][n] = __builtin_amdgcn_mfma_f32_16x16x32_bf16(Bt[n][k], At[m][k], acc[ai][bj][m][n], 0, 0, 0); __builtin_amdgcn_s_setprio(0); } while (0)
#define PG8_WAIT_V(n) asm volatile("s_waitcnt vmcnt(" #n ")" ::: "memory")
#define PG8_WAIT_L(n) asm volatile("s_waitcnt lgkmcnt(" #n ")" ::: "memory")
#define PG8_BAR __builtin_amdgcn_s_barrier()
#define PG8_SCHED __builtin_amdgcn_sched_barrier(0)
    Unit cur, nxt; int ui = 0;
    if (!S.next(0, cur)) return;
    f32x4 acc[2][2][MB][2];
#pragma unroll
    for (int a = 0; a < 2; ++a)
#pragma unroll
        for (int b = 0; b < 2; ++b)
#pragma unroll
            for (int m = 0; m < MB; ++m)
#pragma unroll
                for (int n = 0; n < 2; ++n) acc[a][b][m][n] = (f32x4){0.f, 0.f, 0.f, 0.f};
    bf16x8 At[MB][2], B0[2][2], B1[2][2];
    const char* cA = (const char*)g.A + (size_t)cur.pm * tstepA; const char* cB = (const char*)g.Bt + (size_t)cur.pn * tstep;
    PG8_STAGE(PG8_SB(0, 0), cB, voffB); PG8_STAGE(PG8_SA(0, 0), cA, voffA); PG8_STAGE(PG8_SB(0, 1), cB + hstep, voffB); PG8_STAGE(PG8_SA(0, 1), cA + hstepA, voffA);
    if (wr == 1) PG8_BAR;
    PG8_WAIT_V(4); PG8_BAR;
    PG8_STAGE(PG8_SB(1, 0), cB + kstep, voffB); PG8_STAGE(PG8_SA(1, 0), cA + kstep, voffA); PG8_STAGE(PG8_SB(1, 1), cB + hstep + kstep, voffB);
    PG8_WAIT_V(6); PG8_BAR;
    for (;;) {
        const bool has_next = S.next(ui + 1, nxt);
        const char* nA = has_next ? (const char*)g.A + (size_t)nxt.pm * tstepA : cA; const char* nB = has_next ? (const char*)g.Bt + (size_t)nxt.pn * tstep : cB;
        for (int t = 0; t < nt; t += 2) {
            const bool last = (t == nt - 2);
            const char* a1 = cA + (size_t)(t + 1) * kstep;
            const char* a2 = last ? nA : cA + (size_t)(t + 2) * kstep; const char* b2 = last ? nB : cB + (size_t)(t + 2) * kstep;
            const char* a3 = a2 + kstep; const char* b3 = b2 + kstep;
            PG8_LDB(B0, 0, 0); PG8_SCHED; PG8_LDA(At, 0, 0); PG8_STAGE(PG8_SA(1, 1), a1 + hstepA, voffA);
            PG8_WAIT_L(8); PG8_BAR; PG8_WAIT_L(0); PG8_MMA(0, 0, At, B0); PG8_BAR; PG8_SCHED;
            PG8_LDB(B1, 0, 1); PG8_STAGE(PG8_SB(0, 0), b2, voffB);
            PG8_BAR; PG8_WAIT_L(0); PG8_MMA(0, 1, At, B1); PG8_BAR;
            PG8_LDA(At, 0, 1); PG8_STAGE(PG8_SA(0, 0), a2, voffA);
            PG8_BAR; PG8_WAIT_L(0); PG8_MMA(1, 0, At, B0); PG8_BAR; PG8_SCHED;
            PG8_STAGE(PG8_SB(0, 1), b2 + hstep, voffB);
            PG8_WAIT_V(6); PG8_BAR; PG8_MMA(1, 1, At, B1); PG8_BAR;
            PG8_LDB(B0, 1, 0); PG8_SCHED; PG8_LDA(At, 1, 0); PG8_STAGE(PG8_SA(0, 1), a2 + hstepA, voffA);
            PG8_WAIT_L(8); PG8_BAR; PG8_WAIT_L(0); PG8_MMA(0, 0, At, B0); PG8_BAR; PG8_SCHED;
            PG8_LDB(B1, 1, 1); PG8_STAGE(PG8_SB(1, 0), b3, voffB);
            PG8_BAR; PG8_WAIT_L(0); PG8_MMA(0, 1, At, B1); PG8_BAR;
            PG8_LDA(At, 1, 1); PG8_STAGE(PG8_SA(1, 0), a3, voffA);
            PG8_BAR; PG8_WAIT_L(0); PG8_MMA(1, 0, At, B0); PG8_BAR; PG8_SCHED;
            PG8_STAGE(PG8_SB(1, 1), b3 + hstep, voffB);
            PG8_WAIT_V(6); PG8_BAR; PG8_MMA(1, 1, At, B1); PG8_BAR;
        }
        if constexpr (!Epi::AFTER_DRAIN) E(acc, cur, wr, wc, fr, fq);
        if (!has_next) break;
#pragma unroll
        for (int a = 0; a < 2; ++a)
#pragma unroll
            for (int b = 0; b < 2; ++b)
#pragma unroll
                for (int m = 0; m < MB; ++m)
#pragma unroll
                    for (int n = 0; n < 2; ++n) acc[a][b][m][n] = (f32x4){0.f, 0.f, 0.f, 0.f};
        cur = nxt; cA = nA; cB = nB; ++ui;
    }
    PG8_WAIT_V(0);
    if (wr == 0) PG8_BAR;
    PG8_BAR;
    if constexpr (Epi::AFTER_DRAIN) E.fused(acc, cur, wr, wc, fr, fq, lds, wid, lane);
#undef PG8_SA
#undef PG8_SB
#undef PG8_STAGE
#undef PG8_LDA
#undef PG8_LDB
#undef PG8_MMA
#undef PG8_WAIT_V
#undef PG8_WAIT_L
#undef PG8_BAR
#undef PG8_SCHED
}
}
using pg8::Unit;


template <int MB> struct EpiZ {
    static constexpr bool PERM = true, AFTER_DRAIN = false;
    bf16_t* O;
    __device__ __forceinline__ void operator()(const f32x4 (&acc)[2][2][MB][2], const Unit& u, int wr, int wc, int fr, int fq) const {
        const int row0 = u.pm * 64 * MB + wr * 16 * MB + fr, col0 = u.pn * 256 + wc * 32 + 8 * fq;
#pragma unroll
        for (int ai = 0; ai < 2; ++ai)
#pragma unroll
            for (int m = 0; m < MB; ++m) { bf16_t* rowp = O + (size_t)(row0 + ai * 32 * MB + m * 16) * DIN + col0;
#pragma unroll
                for (int bj = 0; bj < 2; ++bj) { const f32x4 v0 = acc[ai][bj][m][0], v1 = acc[ai][bj][m][1];
                    u32x4 w; w.x = cvt_pk_bf16(v0[0], v0[1]); w.y = cvt_pk_bf16(v0[2], v0[3]); w.z = cvt_pk_bf16(v1[0], v1[1]); w.w = cvt_pk_bf16(v1[2], v1[3]);
                    *(u32x4*)(rowp + bj * 128) = w; } }
    }
};

template <int MB> struct EpiG2 {
    static constexpr bool PERM = true, AFTER_DRAIN = false;
    const float* xp; const float* xs; const float* mod; const float* norm2; float* out; bf16_t* h2; float* ssq;
    __device__ __forceinline__ void operator()(const f32x4 (&acc)[2][2][MB][2], const Unit& u, int wr, int wc, int fr, int fq) const {
        const int rb0 = u.pm * 64 * MB + wr * 16 * MB, col0 = u.pn * 256 + wc * 32 + 8 * fq, lane = fr + 16 * fq;
        f32x4 nv[2][2];
#pragma unroll
        for (int bj = 0; bj < 2; ++bj)
#pragma unroll
            for (int n = 0; n < 2; ++n) nv[bj][n] = *(const f32x4*)(norm2 + col0 + bj * 128 + 4 * n);
#pragma unroll
        for (int ai = 0; ai < 2; ++ai)
#pragma unroll
            for (int m = 0; m < MB; ++m) { const int rb = rb0 + ai * 32 * MB + m * 16, row = rb + fr; const int b = bidx_of_row(rb);
                const float* mb = mod + b * 6144 + col0;
                const float* xr = (rb < NCTX ? xp + (size_t)row * DM : xs + (size_t)(row - NCTX) * DM) + col0;
                const size_t off = (size_t)row * DM + col0; float ss = 0.f;
#pragma unroll
                for (int bj = 0; bj < 2; ++bj) {
                    const f32x4 x0 = *(const f32x4*)(xr + bj * 128), x1 = *(const f32x4*)(xr + bj * 128 + 4);
                    const f32x4 g0 = *(const f32x4*)(mb + 2048 + bj * 128), g1 = *(const f32x4*)(mb + 2048 + bj * 128 + 4);
                    const f32x4 c0 = *(const f32x4*)(mb + 4096 + bj * 128), c1 = *(const f32x4*)(mb + 4096 + bj * 128 + 4);
                    const f32x4 v0 = x0 + g0 * acc[ai][bj][m][0], v1 = x1 + g1 * acc[ai][bj][m][1];
                    *(f32x4*)(out + off + bj * 128) = v0; *(f32x4*)(out + off + bj * 128 + 4) = v1;
                    ss += (v0[0] * v0[0] + v0[1] * v0[1]) + (v0[2] * v0[2] + v0[3] * v0[3]) + (v1[0] * v1[0] + v1[1] * v1[1]) + (v1[2] * v1[2] + v1[3] * v1[3]);
                    const f32x4 h0 = v0 * (nv[bj][0] * (c0 + 1.0f)), h1 = v1 * (nv[bj][1] * (c1 + 1.0f));
                    u32x4 w; w.x = cvt_pk_bf16(h0[0], h0[1]); w.y = cvt_pk_bf16(h0[2], h0[3]); w.z = cvt_pk_bf16(h1[0], h1[1]); w.w = cvt_pk_bf16(h1[2], h1[3]);
                    *(u32x4*)(h2 + off + bj * 128) = w; }
                ss += shfl_f(ss, lane ^ 16); ss += shfl_f(ss, lane ^ 32);
                if (fq == 0) ssq[(size_t)row * 16 + u.pn * 4 + wc] = ss; }
    }
};

template <int MB> struct EpiG4 {
    static constexpr bool PERM = true, AFTER_DRAIN = true;
    const float* mod; const float* x1; const float* fnorm; float* out; unsigned* slot; unsigned* cnt;
    __device__ __forceinline__ void fused(f32x4 (&acc)[2][2][MB][2], const Unit& u, int wr, int wc, int fr, int fq, LAS unsigned char* lds, int wid, int lane) const {
        constexpr int RM = 64 * MB;
        const int rl0 = wr * 16 * MB + fr, row0 = u.pm * RM + rl0, col0 = u.pn * 256 + wc * 32 + 8 * fq, tid = wid * 64 + lane;
        LAS float* Pt = (LAS float*)lds;
        LAS float* St = (LAS float*)(lds + 4096);
#pragma unroll
        for (int ai = 0; ai < 2; ++ai)
#pragma unroll
            for (int m = 0; m < MB; ++m) { const int dr = ai * 32 * MB + m * 16; const size_t off = (size_t)(row0 + dr) * DM + col0; float ss = 0.f;
                const float* mb = mod + bidx_of_row(u.pm * RM + wr * 16 * MB + dr) * 6144 + 5120 + col0;
#pragma unroll
                for (int bj = 0; bj < 2; ++bj) {
                    const f32x4 x0 = *(const f32x4*)(x1 + off + bj * 128), xb1 = *(const f32x4*)(x1 + off + bj * 128 + 4);
                    const f32x4 g0 = *(const f32x4*)(mb + bj * 128), g1 = *(const f32x4*)(mb + bj * 128 + 4);
                    const f32x4 v0 = x0 + g0 * acc[ai][bj][m][0], v1 = xb1 + g1 * acc[ai][bj][m][1];
                    acc[ai][bj][m][0] = v0; acc[ai][bj][m][1] = v1;
                    ss += (v0[0] * v0[0] + v0[1] * v0[1]) + (v0[2] * v0[2] + v0[3] * v0[3]) + (v1[0] * v1[0] + v1[1] * v1[1]) + (v1[2] * v1[2] + v1[3] * v1[3]); }
                ss += shfl_f(ss, lane ^ 16); ss += shfl_f(ss, lane ^ 32);
                if (fq == 0) Pt[(dr + rl0) * 4 + wc] = ss; }
        asm volatile("s_waitcnt lgkmcnt(0)" ::: "memory"); __builtin_amdgcn_s_barrier(); asm volatile("" ::: "memory");
        if (tid < RM) { const f32x4 pr = *(const LAS f32x4*)(Pt + tid * 4); const float tot = (pr[0] + pr[1]) + (pr[2] + pr[3]);
            __hip_atomic_store(slot + (size_t)(u.pm * RM + tid) * 4 + u.pn, __float_as_uint(tot), __ATOMIC_RELAXED, __HIP_MEMORY_SCOPE_AGENT); }
        asm volatile("s_waitcnt vmcnt(0)" ::: "memory");
        if (wid < MB && lane == 0) __hip_atomic_fetch_add(cnt + 64 * u.pm, 1u, __ATOMIC_RELAXED, __HIP_MEMORY_SCOPE_AGENT);
        if (wid == 0) { unsigned sp = 0;
            while ((unsigned)__builtin_amdgcn_readfirstlane(__hip_atomic_load(cnt + 64 * u.pm, __ATOMIC_RELAXED, __HIP_MEMORY_SCOPE_AGENT)) < 4u * MB) { __builtin_amdgcn_s_sleep(2); if (++sp > (1u << 22)) break; }
            __builtin_amdgcn_fence(__ATOMIC_ACQUIRE, "agent");
            asm volatile("s_waitcnt vmcnt(0)" ::: "memory"); }
        asm volatile("s_waitcnt lgkmcnt(0)" ::: "memory"); __builtin_amdgcn_s_barrier(); asm volatile("" ::: "memory");
        if (tid < RM) { const unsigned* sl = slot + (size_t)(u.pm * RM + tid) * 4; float tot = 0.f;
#pragma unroll
            for (int t = 0; t < 4; ++t) tot += __uint_as_float(__hip_atomic_load(sl + t, __ATOMIC_RELAXED, __HIP_MEMORY_SCOPE_AGENT));
            St[tid] = __builtin_amdgcn_rsqf(tot * (1.0f / 1024.0f) + EPS); }
        asm volatile("s_waitcnt lgkmcnt(0)" ::: "memory"); __builtin_amdgcn_s_barrier(); asm volatile("" ::: "memory");
        f32x4 fn[2][2];
#pragma unroll
        for (int bj = 0; bj < 2; ++bj)
#pragma unroll
            for (int n = 0; n < 2; ++n) fn[bj][n] = *(const f32x4*)(fnorm + col0 + bj * 128 + 4 * n);
#pragma unroll
        for (int ai = 0; ai < 2; ++ai)
#pragma unroll
            for (int m = 0; m < MB; ++m) { const int dr = ai * 32 * MB + m * 16; const size_t off = (size_t)(row0 + dr) * DM + col0; const float inv = St[dr + rl0];
#pragma unroll
                for (int bj = 0; bj < 2; ++bj) { *(f32x4*)(out + off + bj * 128) = acc[ai][bj][m][0] * inv * fn[bj][0]; *(f32x4*)(out + off + bj * 128 + 4) = acc[ai][bj][m][1] * inv * fn[bj][1]; } }
    }
};

struct EpiG3 {
    static constexpr bool PERM = true, AFTER_DRAIN = false;
    const float* ssq2; const float* shw; const float* cw; const float* cb; bf16_t* act; LAS float* ex;
    __device__ __forceinline__ void operator()(f32x4 (&acc)[2][2][4][2], const Unit& u, int wr, int wc, int fr_, int fq_) const {
        const bool ctx = u.pm < 16;
        const int b = ctx ? 0 : 1 + ((u.pm - 16) >> 3);
        int lane; asm volatile("v_mbcnt_lo_u32_b32 %0, -1, 0\n\tv_mbcnt_hi_u32_b32 %0, -1, %0" : "=v"(lane));
        const int fr = lane & 15, fq = lane >> 4;
        const int row0 = u.pm * 256 + wr * 64 + fr;
        f32x4 cst[2][4][2];
#pragma unroll
        for (int bj = 0; bj < 2; ++bj) { const unsigned co = bj * DFF + u.pn * 128 + wc * 32 + 8 * fq;
            cst[0][0][bj] = *(const f32x4*)(cw + co); cst[0][1][bj] = *(const f32x4*)(cw + DFF2 + co); cst[0][2][bj] = *(const f32x4*)(cw + 2 * DFF2 + co); cst[0][3][bj] = *(const f32x4*)(cb + co); }
        {
            f32x4 sq[2][4];
#pragma unroll
            for (int ai = 0; ai < 2; ++ai)
#pragma unroll
                for (int m = 0; m < 4; ++m) sq[ai][m] = *(const f32x4*)(ssq2 + (unsigned)((row0 + ai * 128 + m * 16) * 16 + 4 * fq));
            float inv[2][4];
#pragma unroll
            for (int ai = 0; ai < 2; ++ai)
#pragma unroll
                for (int m = 0; m < 4; ++m) { float t = (sq[ai][m][0] + sq[ai][m][1]) + (sq[ai][m][2] + sq[ai][m][3]);
                    t += shfl_f(t, lane ^ 16); t += shfl_f(t, lane ^ 32);
                    inv[ai][m] = __builtin_amdgcn_rsqf(t * (1.0f / 1024.0f) + EPS); }
#pragma unroll
            for (int bj = 0; bj < 2; ++bj)
#pragma unroll
                for (int n = 0; n < 2; ++n) { const f32x4 sh = *(const f32x4*)(shw + (unsigned)(b * 6144 + u.pn * 256 + bj * 128 + wc * 32 + 8 * fq + 4 * n));
#pragma unroll
                    for (int ai = 0; ai < 2; ++ai)
#pragma unroll
                        for (int m = 0; m < 4; ++m) acc[ai][bj][m][n] = acc[ai][bj][m][n] * inv[ai][m] + sh; }
#pragma unroll
            for (int ai = 0; ai < 2; ++ai)
#pragma unroll
                for (int m = 0; m < 4; ++m) asm volatile("" : "+v"(acc[ai][0][m][0]), "+v"(acc[ai][0][m][1]), "+v"(acc[ai][1][m][0]), "+v"(acc[ai][1][m][1]));
        }
        if (ctx) {
            if (fr == 0) {
#pragma unroll
                for (int ai = 0; ai < 2; ++ai)
#pragma unroll
                    for (int bj = 0; bj < 2; ++bj)
#pragma unroll
                        for (int n = 0; n < 2; ++n) *(LAS f32x4*)(ex + ((2 * ai + wr) * 2 + 0) * 256 + bj * 128 + wc * 32 + 8 * fq + 4 * n) = acc[ai][bj][0][n];
            }
            if (fr == 15) {
#pragma unroll
                for (int ai = 0; ai < 2; ++ai)
#pragma unroll
                    for (int bj = 0; bj < 2; ++bj)
#pragma unroll
                        for (int n = 0; n < 2; ++n) *(LAS f32x4*)(ex + ((2 * ai + wr) * 2 + 1) * 256 + bj * 128 + wc * 32 + 8 * fq + 4 * n) = acc[ai][bj][3][n];
            }
            asm volatile("s_waitcnt lgkmcnt(0)" ::: "memory"); __builtin_amdgcn_s_barrier(); asm volatile("" ::: "memory");
            __builtin_amdgcn_s_barrier(); asm volatile("" ::: "memory");
        }
#pragma unroll
        for (int bj = 0; bj < 2; ++bj) { const unsigned co = bj * DFF + u.pn * 128 + wc * 32 + 8 * fq + 4;
            cst[1][0][bj] = *(const f32x4*)(cw + co); cst[1][1][bj] = *(const f32x4*)(cw + DFF2 + co); cst[1][2][bj] = *(const f32x4*)(cw + 2 * DFF2 + co); cst[1][3][bj] = *(const f32x4*)(cb + co); }
#pragma unroll
        for (int ai = 0; ai < 2; ++ai) {
            u32x2 keep[4];
#pragma unroll
            for (int n = 0; n < 2; ++n) {
                const int s = 2 * ai + wr;
                f32x4 og[4];
#pragma unroll
                for (int bj = 0; bj < 2; ++bj) {
                    const f32x4 w0 = cst[n][0][bj], w1 = cst[n][1][bj], w2 = cst[n][2][bj], cbv = cst[n][3][bj];
                    f32x4 pv = (f32x4){0.f, 0.f, 0.f, 0.f}, nv = (f32x4){0.f, 0.f, 0.f, 0.f};
                    if (ctx) { const int cl = bj * 128 + wc * 32 + 8 * fq + 4 * n;
                        if (s > 0) pv = *(const LAS f32x4*)(ex + ((s - 1) * 2 + 1) * 256 + cl);
                        if (s < 3) nv = *(const LAS f32x4*)(ex + ((s + 1) * 2 + 0) * 256 + cl); }
#pragma unroll
                    for (int m = 0; m < 4; ++m) {
                        f32x4 o;
#pragma unroll
                        for (int j = 0; j < 4; ++j) {
                            const float zc = acc[ai][bj][m][n][j];
                            const float oldp = m > 0 ? __int_as_float(__builtin_amdgcn_mov_dpp(__float_as_int(acc[ai][bj][m > 0 ? m - 1 : 0][n][j]), 0x121, 0xf, 0xf, false)) : pv[j];
                            const float prev = dpp_f<0x111>(oldp, zc);
                            const float oldn = m < 3 ? __int_as_float(__builtin_amdgcn_mov_dpp(__float_as_int(acc[ai][bj][m < 3 ? m + 1 : 3][n][j]), 0x12F, 0xf, 0xf, false)) : nv[j];
                            const float next = dpp_f<0x101>(oldn, zc);
                            o[j] = cbv[j] + w0[j] * prev + w1[j] * zc + w2[j] * next;
                        }
                        if (bj == 0) {
#pragma unroll
                            for (int j = 0; j < 4; ++j) og[m][j] = siluf_(o[j]);
                        } else {
                            const f32x4 a = og[m] * o;
                            u32x2 w; w.x = cvt_pk_bf16(a[0], a[1]); w.y = cvt_pk_bf16(a[2], a[3]);
                            if (n == 0) keep[m] = w;
                            else { u32x4 ww; ww.x = keep[m].x; ww.y = keep[m].y; ww.z = w.x; ww.w = w.y;
                                *(u32x4*)(act + (unsigned)((row0 + ai * 128 + m * 16) * DFF + u.pn * 128 + wc * 32 + 8 * fq)) = ww; }
                        }
                    }
                    asm volatile("" ::: "memory");
                }
            }
        }
    }
};

__device__ __forceinline__ void p0_mod_item(KP p, LAS unsigned char* lds, int item, const int wave) {
    const int lane = lane_id(), tid = wave * 64 + lane;
    LAS float* sc = (LAS float*)lds;
    LAS float* red = (LAS float*)(lds + 20480);
    const float* c = p->in[3]; const float* cctx = p->in[4]; const float* wada = p->in[7]; const float* bada = p->in[8];
    float* mod = (float*)(p->ws + WS_MOD);
    for (int i = tid; i < 5120; i += NTHREADS) { const int b = i >> 10, k = i & 1023; const float v = b == 0 ? cctx[k] : c[(b - 1) * 1024 + k]; sc[i] = siluf_(v); }
    __syncthreads();
    const int col0 = item * 32, cq = lane & 7, rg = lane >> 3;
    float acc[5][4];
#pragma unroll
    for (int b = 0; b < 5; ++b)
#pragma unroll
        for (int j = 0; j < 4; ++j) acc[b][j] = 0.f;
    const float* wp = wada + col0 + 4 * cq;
#pragma unroll 4
    for (int s = 0; s < 16; ++s) { const int k = 64 * s + 8 * wave + rg; const f32x4 w = __builtin_nontemporal_load((const f32x4*)(wp + (size_t)k * 6144));
#pragma unroll
        for (int b = 0; b < 5; ++b) { const float sb = sc[b * 1024 + k];
#pragma unroll
            for (int j = 0; j < 4; ++j) acc[b][j] += sb * w[j]; } }
#pragma unroll
    for (int b = 0; b < 5; ++b)
#pragma unroll
        for (int j = 0; j < 4; ++j) { float v = acc[b][j]; v += shfl_f(v, lane ^ 8); v += shfl_f(v, lane ^ 16); v += shfl_f(v, lane ^ 32); if (rg == 0) red[(wave * 5 + b) * 32 + 4 * cq + j] = v; }
    __syncthreads();
    if (tid < 160) { const int b = tid >> 5, cc = tid & 31; float s = 0.f;
#pragma unroll
        for (int w = 0; w < 8; ++w) s += red[(w * 5 + b) * 32 + cc];
        mod[b * 6144 + col0 + cc] = s + bada[col0 + cc]; }
    __syncthreads();
}

struct TrTile { const float* src; bf16_t* dst; int N, k0, n0, Kd, drow0; };
__device__ __forceinline__ TrTile p0_tile_desc(KP p, int idx) {
    TrTile t;
    if (idx < 512) { const int kt = idx >> 5, nt = idx & 31; t = TrTile{p->in[9], (bf16_t*)(p->ws + WS_BT1), DIN, 64 * kt, 64 * nt, 1024, 64 * nt}; }
    else if (idx < 768) { idx -= 512; const int kt = idx >> 4, nt = idx & 15; t = TrTile{p->in[21], (bf16_t*)(p->ws + WS_BT2), DM, 64 * kt, 64 * nt, 1024, 64 * nt}; }
    else if (idx < 2304) { idx -= 768; const int kt = idx / 96, nt = idx % 96; const int n0 = 64 * nt; const int nn = n0 < DFF ? n0 : n0 - DFF;
        t = TrTile{p->in[22], (bf16_t*)(p->ws + WS_BT3), DFF2, 64 * kt, n0, 1024, (nn >> 7) * 256 + (n0 < DFF ? 0 : 128) + (nn & 127)}; }
    else if (idx < 3072) { idx -= 2304; const int kt = idx >> 4, nt = idx & 15; t = TrTile{p->in[25], (bf16_t*)(p->ws + WS_BT4), DM, 64 * kt, 64 * nt, DFF, 64 * nt}; }
    else { idx -= 3072; const int type = idx >> 4, rem = idx & 15; t = TrTile{(type ? p->in[14] : p->in[12]) + rem * 4096, (bf16_t*)(p->ws + WS_WG) + idx * 4096, 64, 0, 0, 64, 0}; }
    return t;
}

__device__ __forceinline__ void phase0(KP p, LAS unsigned char* lds, const int wave) {
    constexpr int NMOD = 192, NTR = 3104 / 4;
    const int tid = wave * 64 + lane_id();
    for (int it = blockIdx.x; it < NMOD + NTR; it += gridDim.x) {
        if (it < NMOD) { p0_mod_item(p, lds, it, wave); continue; }
        const int idx0 = (it - NMOD) * 4; LAS float* tile = (LAS float*)lds;
        f32x4 v[4][2];
        { const int r = tid >> 4, c4 = (tid & 15) * 4;
#pragma unroll
          for (int q = 0; q < 4; ++q) { const TrTile t = p0_tile_desc(p, idx0 + q);
#pragma unroll
              for (int ps = 0; ps < 2; ++ps) v[q][ps] = __builtin_nontemporal_load((const f32x4*)(t.src + (size_t)(t.k0 + r + 32 * ps) * t.N + t.n0 + c4)); }
#pragma unroll
          for (int q = 0; q < 4; ++q)
#pragma unroll
              for (int ps = 0; ps < 2; ++ps)
#pragma unroll
                  for (int j = 0; j < 4; ++j) tile[q * 4160 + (r + 32 * ps) * 65 + c4 + j] = v[q][ps][j]; }
        __syncthreads();
        { const int n = tid >> 3, kk = (tid & 7) * 8;
#pragma unroll
          for (int q = 0; q < 4; ++q) { const TrTile t = p0_tile_desc(p, idx0 + q); float x[8];
#pragma unroll
              for (int i = 0; i < 8; ++i) x[i] = tile[q * 4160 + (kk + i) * 65 + n];
              u32x4 w; w.x = cvt_pk_bf16(x[0], x[1]); w.y = cvt_pk_bf16(x[2], x[3]); w.z = cvt_pk_bf16(x[4], x[5]); w.w = cvt_pk_bf16(x[6], x[7]);
              *(u32x4*)(t.dst + (size_t)(t.drow0 + n) * t.Kd + t.k0 + kk) = w; } }
        __syncthreads();
    }
}

__device__ __forceinline__ void p1_rows(KP p, const float* mod, int row_begin, int nrows, const int lane) {
    f32x4 ns[4], sh[4]; int bcur = -1;
    for (int r = 0; r < nrows; r += 3) {
        f32x4 v[3][4];
#pragma unroll
        for (int q = 0; q < 3; ++q) { const int row = (r + q < nrows) ? row_begin + r + q : row_begin + r;
            const float* xr = row < NCTX ? p->in[0] + (size_t)row * DM : p->in[1] + (size_t)(row - NCTX) * DM;
#pragma unroll
            for (int i = 0; i < 4; ++i) v[q][i] = *(const f32x4*)(xr + 256 * i + 4 * lane); }
#pragma unroll
        for (int q = 0; q < 3; ++q) { if (r + q < nrows) { const int row = row_begin + r + q; const int b = bidx_of_row(row);
            if (b != bcur) { bcur = b;
#pragma unroll
                for (int i = 0; i < 4; ++i) { const int c = 256 * i + 4 * lane;
                    ns[i] = *(const f32x4*)(p->in[5] + c) * (*(const f32x4*)(mod + b * 6144 + 1024 + c) + 1.0f); sh[i] = *(const f32x4*)(mod + b * 6144 + c); } }
            float ss = 0.f;
#pragma unroll
            for (int i = 0; i < 4; ++i) ss += (v[q][i][0] * v[q][i][0] + v[q][i][1] * v[q][i][1]) + (v[q][i][2] * v[q][i][2] + v[q][i][3] * v[q][i][3]);
#pragma unroll
            for (int o = 1; o < 64; o <<= 1) ss += shfl_f(ss, lane ^ o);
            const float inv = __builtin_amdgcn_rsqf(ss * (1.0f / 1024.0f) + EPS);
            bf16_t* hp = (bf16_t*)(p->ws + WS_H1) + (size_t)row * DM;
#pragma unroll
            for (int i = 0; i < 4; ++i) { const f32x4 h = v[q][i] * inv * ns[i] + sh[i]; u32x2 w; w.x = cvt_pk_bf16(h[0], h[1]); w.y = cvt_pk_bf16(h[2], h[3]); *(u32x2*)(hp + 256 * i + 4 * lane) = w; } } }
    }
}
__device__ __forceinline__ void p1_shw(KP p, const float* mod, int r0, int nrows, const int lane) {
    float s2[5][16];
#pragma unroll
    for (int b = 0; b < 5; ++b)
#pragma unroll
        for (int i = 0; i < 2; ++i) { const f32x4 a = *(const f32x4*)(mod + b * 6144 + 3072 + 512 * i + 8 * lane), c = *(const f32x4*)(mod + b * 6144 + 3072 + 512 * i + 8 * lane + 4);
#pragma unroll
            for (int j = 0; j < 4; ++j) { s2[b][8 * i + j] = a[j]; s2[b][8 * i + 4 + j] = c[j]; } }
    const bf16_t* bt3 = (const bf16_t*)(p->ws + WS_BT3);
    float* shw = (float*)(p->ws + WS_SHW);
    for (int r = 0; r < nrows; ++r) { const int n = r0 + r; float wv[16];
#pragma unroll
        for (int i = 0; i < 2; ++i) { const u32x4 q = *(const u32x4*)(bt3 + (size_t)n * 1024 + 512 * i + 8 * lane);
            wv[8 * i + 0] = bflo(q.x); wv[8 * i + 1] = bfhi(q.x); wv[8 * i + 2] = bflo(q.y); wv[8 * i + 3] = bfhi(q.y); wv[8 * i + 4] = bflo(q.z); wv[8 * i + 5] = bfhi(q.z); wv[8 * i + 6] = bflo(q.w); wv[8 * i + 7] = bfhi(q.w); }
#pragma unroll
        for (int b = 0; b < 5; ++b) { float d = 0.f;
#pragma unroll
            for (int i = 0; i < 16; ++i) d += wv[i] * s2[b][i];
#pragma unroll
            for (int o = 1; o < 64; o <<= 1) d += shfl_f(d, lane ^ o);
            if (lane == 0) shw[b * 6144 + n] = d; } }
}
__device__ __forceinline__ void phase1(KP p, const int wave) {
    const int lane = lane_id();
    const float* mod = (const float*)(p->ws + WS_MOD);
    if (blockIdx.x == gridDim.x - 1) { float* sp = (float*)(p->ws + WS_SP8);
        for (int i = wave * 64 + lane; i < 1024; i += NTHREADS) sp[i] = -8.0f * log1pf(__expf(-p->in[16][i])); }
    const int nw = gridDim.x * 8, w = blockIdx.x * 8 + wave;
    { const int per = (NTOK + nw - 1) / nw; const int r0 = w * per; const int n = r0 >= NTOK ? 0 : (NTOK - r0 < per ? NTOK - r0 : per); p1_rows(p, mod, r0, n, lane); }
    { const int per = (DFF2 + nw - 1) / nw; const int r0 = w * per; const int n = r0 >= DFF2 ? 0 : (DFF2 - r0 < per ? DFF2 - r0 : per); p1_shw(p, mod, r0, n, lane); }
}

__device__ __forceinline__ int vt_off(int ch, int q) { const int sw = (ch & 15) ^ ((ch >> 3) & 15); return ch * 256 + ((((q >> 3) ^ sw) & 15) << 4) + ((q & 7) << 1); }

__device__ __forceinline__ void sgu_item(KP p, LAS unsigned char* lds, int item, const int wave) {
    const int lane = lane_id(), tid = wave * 64 + lane, fr = lane & 15, fq = lane >> 4;
    const int chunk = item >> 2, g = item & 3, t0 = chunk * 128;
    const bf16_t* Z = (const bf16_t*)(p->ws + WS_Z);
    {
        const int cg = tid & 15, qg = tid >> 4, ch0 = 8 * cg, q0 = 4 * qg;
        float v[4][8];
#pragma unroll
        for (int r = 0; r < 4; ++r) { const u32x4 w = *(const u32x4*)(Z + (size_t)(t0 + q0 + r) * DIN + 1536 + 128 * g + ch0);
            v[r][0] = geluf_(bflo(w.x)); v[r][1] = geluf_(bfhi(w.x)); v[r][2] = geluf_(bflo(w.y)); v[r][3] = geluf_(bfhi(w.y));
            v[r][4] = geluf_(bflo(w.z)); v[r][5] = geluf_(bfhi(w.z)); v[r][6] = geluf_(bflo(w.w)); v[r][7] = geluf_(bfhi(w.w)); }
#pragma unroll
        for (int i = 0; i < 8; ++i) { u32x2 w; w.x = cvt_pk_bf16(v[0][i], v[1][i]); w.y = cvt_pk_bf16(v[2][i], v[3][i]); *(LAS u32x2*)(lds + vt_off(ch0 + i, q0)) = w; }
    }
    unsigned short uv16[4][8]; float bsv4[4];
#pragma unroll
    for (int jj = 0; jj < 4; ++jj) { const int pp = 16 * wave + 4 * fq + jj; bsv4[jj] = p->in[18][g * 128 + pp];
#pragma unroll
        for (int nt = 0; nt < 8; ++nt) uv16[jj][nt] = Z[(size_t)(t0 + pp) * DIN + 1024 + 128 * g + 16 * nt + fr]; }
    const float* Ws = p->in[17] + (size_t)g * 16384;
    bf16x8 af[4];
#pragma unroll
    for (int kk = 0; kk < 4; ++kk) { const float* ap = Ws + (16 * wave + fr) * 128 + 32 * kk + 8 * fq; const f32x4 a0 = *(const f32x4*)ap, a1 = *(const f32x4*)(ap + 4);
        u32x4 w; w.x = cvt_pk_bf16(a0[0], a0[1]); w.y = cvt_pk_bf16(a0[2], a0[3]); w.z = cvt_pk_bf16(a1[0], a1[1]); w.w = cvt_pk_bf16(a1[2], a1[3]); af[kk] = __builtin_bit_cast(bf16x8, w); }
    __syncthreads();
    f32x4 acc[8];
#pragma unroll
    for (int nt = 0; nt < 8; ++nt) { acc[nt] = (f32x4){0.f, 0.f, 0.f, 0.f};
#pragma unroll
        for (int kk = 0; kk < 4; ++kk) { const bf16x8 bfr = *(const LAS bf16x8*)(lds + vt_off(16 * nt + fr, 32 * kk + 8 * fq));
            acc[nt] = __builtin_amdgcn_mfma_f32_16x16x32_bf16(af[kk], bfr, acc[nt], 0, 0, 0); } }
    bf16_t* osgu = (bf16_t*)(p->ws + WS_OSGU); float* sgp = (float*)(p->ws + WS_SGP);
    float ssq[4] = {0.f, 0.f, 0.f, 0.f};
#pragma unroll
    for (int jj = 0; jj < 4; ++jj) { const int pp = 16 * wave + 4 * fq + jj, tok = t0 + pp; const float bsv = bsv4[jj];
#pragma unroll
        for (int nt = 0; nt < 8; ++nt) { const int ch = 16 * nt + fr; const float uv = geluf_(bf2f(uv16[jj][nt]));
            const float o = uv * (acc[nt][jj] + bsv); osgu[(size_t)tok * 512 + 128 * g + ch] = (bf16_t)(cvt_pk_bf16(o, o) & 0xffffu); ssq[jj] += o * o; } }
#pragma unroll
    for (int jj = 0; jj < 4; ++jj) { float s = ssq[jj]; s += shfl_f(s, lane ^ 1); s += shfl_f(s, lane ^ 2); s += shfl_f(s, lane ^ 4); s += shfl_f(s, lane ^ 8);
        if (fr == 0) sgp[(size_t)(t0 + 16 * wave + 4 * fq + jj) * 4 + g] = s; }
    __syncthreads();
}

__device__ __forceinline__ unsigned pk_f16(float a, float b) { return __builtin_bit_cast(unsigned, __builtin_amdgcn_cvt_pkrtz(a, b)); }
typedef _Float16 h2_t __attribute__((ext_vector_type(2)));
__device__ __forceinline__ float f16lo(unsigned w) { return (float)__builtin_bit_cast(h2_t, w)[0]; }
__device__ __forceinline__ float f16hi(unsigned w) { return (float)__builtin_bit_cast(h2_t, w)[1]; }

__device__ __forceinline__ void lru_scan_item(KP p, LAS unsigned char* lds, int chunk, const int wave) {
    const int lane = lane_id(), fr = lane & 15, fq = lane >> 4;
    const int h = wave, t0 = chunk * 32;
    const bool ctx = t0 < NCTX;
    const int seq_start = ctx ? (t0 & ~255) : NCTX + ((t0 - NCTX) & ~2047);
    const int seq_end = seq_start + (ctx ? 256 : 2048);
    const bf16_t* Z = (const bf16_t*)(p->ws + WS_Z);
    LAS float* xc = (LAS float*)(lds + wave * 8704);
    {
        const int gc = h * 64 + lane;
        const float c0 = p->in[10][gc], c1 = p->in[10][512 + gc], c2 = p->in[10][1024 + gc], c3 = p->in[10][1536 + gc], cbv = p->in[11][gc];
        float xw[35];
#pragma unroll
        for (int i = 0; i < 35; ++i) { const int t = t0 - 2 + i; xw[i] = (t >= seq_start && t < seq_end) ? bf2f(Z[(size_t)t * DIN + gc]) : 0.f; }
#pragma unroll
        for (int tt = 0; tt < 32; ++tt) xc[tt * 68 + lane] = cbv + c0 * xw[tt] + c1 * xw[tt + 1] + c2 * xw[tt + 2] + c3 * xw[tt + 3];
    }
    bf16x8 af[2][2];
#pragma unroll
    for (int mt = 0; mt < 2; ++mt)
#pragma unroll
        for (int ks = 0; ks < 2; ++ks) { const LAS float* ap = xc + (16 * mt + fr) * 68 + 32 * ks + 8 * fq; const f32x4 a0 = *(const LAS f32x4*)ap, a1 = *(const LAS f32x4*)(ap + 4);
            u32x4 w; w.x = cvt_pk_bf16(a0[0], a0[1]); w.y = cvt_pk_bf16(a0[2], a0[3]); w.z = cvt_pk_bf16(a1[0], a1[1]); w.w = cvt_pk_bf16(a1[2], a1[3]); af[mt][ks] = __builtin_bit_cast(bf16x8, w); }
    const bf16_t* WG = (const bf16_t*)(p->ws + WS_WG);
    float* sumA = (float*)(p->ws + WS_SUMA); float* sumB = (float*)(p->ws + WS_SUMB);
    u32x2* HS = (u32x2*)(p->ws + WS_HS); u32x2* AC = (u32x2*)(p->ws + WS_AC);
    const size_t sbase = (size_t)(chunk * 8 + h) * 8 * 64 + lane;
    float hsum[2][4][4];
#pragma unroll
    for (int d = 0; d < 2; ++d) {
        bf16x8 wfr[4][4]; float bavv[4], bxvv[4], lamv[4];
#pragma unroll
        for (int nt = 0; nt < 4; ++nt) {
            const bf16_t* wa = WG + (size_t)((0 * 2 + d) * 8 + h) * 4096 + (16 * nt + fr) * 64 + 8 * fq;
            const bf16_t* wx = WG + (size_t)((1 * 2 + d) * 8 + h) * 4096 + (16 * nt + fr) * 64 + 8 * fq;
            wfr[nt][0] = *(const bf16x8*)wa; wfr[nt][1] = *(const bf16x8*)(wa + 32); wfr[nt][2] = *(const bf16x8*)wx; wfr[nt][3] = *(const bf16x8*)(wx + 32);
            const int gcw = h * 64 + 16 * nt + fr;
            bavv[nt] = p->in[13][d * 512 + gcw]; bxvv[nt] = p->in[15][d * 512 + gcw]; lamv[nt] = ((const float*)(p->ws + WS_SP8))[d * 512 + gcw];
        }
#pragma unroll
        for (int nt = 0; nt < 4; ++nt) {
            const int gc = h * 64 + 16 * nt + fr;
            float av[2][4], bv[2][4];
            {
                f32x4 ga[2], gx[2];
                const bf16x8 ba0 = wfr[nt][0], ba1 = wfr[nt][1], bx0 = wfr[nt][2], bx1 = wfr[nt][3];
#pragma unroll
                for (int mt = 0; mt < 2; ++mt) {
                    f32x4 z = (f32x4){0.f, 0.f, 0.f, 0.f};
                    z = __builtin_amdgcn_mfma_f32_16x16x32_bf16(af[mt][0], ba0, z, 0, 0, 0); ga[mt] = __builtin_amdgcn_mfma_f32_16x16x32_bf16(af[mt][1], ba1, z, 0, 0, 0);
                    z = (f32x4){0.f, 0.f, 0.f, 0.f};
                    z = __builtin_amdgcn_mfma_f32_16x16x32_bf16(af[mt][0], bx0, z, 0, 0, 0); gx[mt] = __builtin_amdgcn_mfma_f32_16x16x32_bf16(af[mt][1], bx1, z, 0, 0, 0);
                }
                const float bav = bavv[nt], bxv = bxvv[nt], lam = lamv[nt];
                const float sp8 = lam;
                constexpr float L2E = 1.44269504f;
                const f32x2 nb1 = (f32x2){-bav * L2E, -bav * L2E}, nb2 = (f32x2){-bxv * L2E, -bxv * L2E};
#pragma unroll
                for (int mt = 0; mt < 2; ++mt)
#pragma unroll
                    for (int hp = 0; hp < 2; ++hp) {
                        const f32x2 g = (f32x2){ga[mt][2 * hp], ga[mt][2 * hp + 1]}, xg = (f32x2){gx[mt][2 * hp], gx[mt][2 * hp + 1]};
                        const f32x2 t1 = g * (-L2E) + nb1, t2 = xg * (-L2E) + nb2;
                        const f32x2 d1 = (f32x2){__builtin_amdgcn_exp2f(t1.x), __builtin_amdgcn_exp2f(t1.y)} + 1.0f, d2 = (f32x2){__builtin_amdgcn_exp2f(t2.x), __builtin_amdgcn_exp2f(t2.y)} + 1.0f;
                        const f32x2 r = (f32x2){frcp(d1.x), frcp(d1.y)}, ig = (f32x2){frcp(d2.x), frcp(d2.y)};
                        const f32x2 la = r * sp8, l2 = la * L2E, x2 = la + la;
                        const f32x2 a = (f32x2){__builtin_amdgcn_exp2f(l2.x), __builtin_amdgcn_exp2f(l2.y)};
                        f32x2 pz = x2 * (1.0f / 720.0f) + (1.0f / 120.0f); pz = pz * x2 + (1.0f / 24.0f); pz = pz * x2 + (1.0f / 6.0f); pz = pz * x2 + 0.5f; pz = pz * x2 + 1.0f;
                        const f32x2 omt = -(x2 * pz), oma = 1.0f - a * a;
                        const f32x2 om = (f32x2){x2.x > -0.5f ? omt.x : oma.x, x2.y > -0.5f ? omt.y : oma.y};
                        const f32x2 xd = (f32x2){xc[(16 * mt + 4 * fq + 2 * hp) * 68 + 16 * nt + fr], xc[(16 * mt + 4 * fq + 2 * hp + 1) * 68 + 16 * nt + fr]};
                        const f32x2 bb = (f32x2){__builtin_amdgcn_sqrtf(om.x), __builtin_amdgcn_sqrtf(om.y)} * (ig * xd);
                        av[mt][2 * hp] = a.x; av[mt][2 * hp + 1] = a.y; bv[mt][2 * hp] = bb.x; bv[mt][2 * hp + 1] = bb.y;
                    }
            }
            float hin = 0.f, acar = 1.f;
#pragma unroll
            for (int mi = 0; mi < 2; ++mi) {
                const int mt = d == 0 ? mi : 1 - mi;
                float a0, a1, a2, a3, b0, b1, b2, b3;
                if (d == 0) { a0 = av[mt][0]; a1 = av[mt][1]; a2 = av[mt][2]; a3 = av[mt][3]; b0 = bv[mt][0]; b1 = bv[mt][1]; b2 = bv[mt][2]; b3 = bv[mt][3]; }
                else { a0 = av[mt][3]; a1 = av[mt][2]; a2 = av[mt][1]; a3 = av[mt][0]; b0 = bv[mt][3]; b1 = bv[mt][2]; b2 = bv[mt][1]; b3 = bv[mt][0]; }
                const float Al = (a0 * a1) * (a2 * a3), Bl = ((b0 * a1 + b1) * a2 + b2) * a3 + b3;
                float hh = hin, Ap = acar, At = 1.f;
#pragma unroll
                for (int k = 0; k < 4; ++k) { const int kq = d == 0 ? k : 3 - k;
                    const float Ak = shfl_f(Al, fr + 16 * kq), Bk = shfl_f(Bl, fr + 16 * kq);
                    const bool before = d == 0 ? (kq < fq) : (kq > fq);
                    if (before) { hh = Ak * hh + Bk; Ap *= Ak; }
                    At *= Ak; }
                const float h0 = a0 * hh + b0, h1 = a1 * h0 + b1, h2 = a2 * h1 + b2, h3 = a3 * h2 + b3;
                const float c0 = Ap * a0, c1 = c0 * a1, c2 = c1 * a2, c3 = c2 * a3;
                u32x2 cw;
                if (d == 0) { hsum[mt][nt][0] = h0; hsum[mt][nt][1] = h1; hsum[mt][nt][2] = h2; hsum[mt][nt][3] = h3; cw.x = pk_f16(c0, c1); cw.y = pk_f16(c2, c3); }
                else { hsum[mt][nt][3] += h0; hsum[mt][nt][2] += h1; hsum[mt][nt][1] += h2; hsum[mt][nt][0] += h3; cw.x = pk_f16(c3, c2); cw.y = pk_f16(c1, c0); }
                AC[(size_t)d * (384 * 8 * 8 * 64) + sbase + (mt * 4 + nt) * 64] = cw;
                hin = shfl_f(h3, fr + (d == 0 ? 48 : 0));
                acar *= At;
            }
            if (fq == 0) { sumA[(size_t)(d * 384 + chunk) * 512 + gc] = acar; sumB[(size_t)(d * 384 + chunk) * 512 + gc] = hin; }
        }
    }
#pragma unroll
    for (int mt = 0; mt < 2; ++mt)
#pragma unroll
        for (int nt = 0; nt < 4; ++nt) { u32x2 hw; hw.x = cvt_pk_bf16(hsum[mt][nt][0], hsum[mt][nt][1]); hw.y = cvt_pk_bf16(hsum[mt][nt][2], hsum[mt][nt][3]); HS[sbase + (mt * 4 + nt) * 64] = hw; }
}

__device__ __forceinline__ void lru_fix_item(KP p, LAS unsigned char* lds, int chunk, const int wave) {
    const int lane = lane_id(), fr = lane & 15, fq = lane >> 4;
    const int h = wave, t0 = chunk * 32;
    const bool ctx = t0 < NCTX;
    const int seq_start = ctx ? (t0 & ~255) : NCTX + ((t0 - NCTX) & ~2047);
    const int seq_end = seq_start + (ctx ? 256 : 2048);
    const bf16_t* Z = (const bf16_t*)(p->ws + WS_Z);
    LAS float* sx = (LAS float*)lds;
    const float* sumA = (const float*)(p->ws + WS_SUMA); const float* sumB = (const float*)(p->ws + WS_SUMB);
    const u32x2* HS = (const u32x2*)(p->ws + WS_HS); const u32x2* AC = (const u32x2*)(p->ws + WS_AC);
    const size_t sbase = (size_t)(chunk * 8 + h) * 8 * 64 + lane;
    f32x4 hs[2][4]; u32x2 hsw[2][4], acf[2][4], acb[2][4]; unsigned short yv[2][4][4];
#pragma unroll
    for (int mt = 0; mt < 2; ++mt)
#pragma unroll
        for (int nt = 0; nt < 4; ++nt) { hsw[mt][nt] = HS[sbase + (mt * 4 + nt) * 64]; acf[mt][nt] = AC[sbase + (mt * 4 + nt) * 64]; acb[mt][nt] = AC[(size_t)(384 * 8 * 8 * 64) + sbase + (mt * 4 + nt) * 64];
#pragma unroll
            for (int jj = 0; jj < 4; ++jj) yv[mt][nt][jj] = Z[(size_t)(t0 + 16 * mt + 4 * fq + jj) * DIN + 512 + h * 64 + 16 * nt + fr]; }
    float car[2];
    const int gcl = h * 64 + lane;
#pragma unroll
    for (int d = 0; d < 2; ++d) {
        float hcar = 0.f;
        if (!ctx) hcar = p->in[2][(size_t)((t0 - NCTX) >> 11) * 1024 + d * 512 + gcl];
        const int step = d == 0 ? 1 : -1;
        int c = d == 0 ? (seq_start >> 5) : (seq_end >> 5) - 1;
        int n = d == 0 ? chunk - c : c - chunk;
        const float* sa = sumA + (size_t)d * 384 * 512 + gcl; const float* sb = sumB + (size_t)d * 384 * 512 + gcl;
        for (; n > 0; n -= 16, c += 16 * step) {
            float a8[16], b8[16];
#pragma unroll
            for (int i = 0; i < 16; ++i) { const bool v = i < n; const int cc = v ? c + i * step : c; const float la = sa[(size_t)cc * 512], lb = sb[(size_t)cc * 512]; a8[i] = v ? la : 1.f; b8[i] = v ? lb : 0.f; }
#pragma unroll
            for (int i = 0; i < 16; ++i) hcar = a8[i] * hcar + b8[i];
        }
        car[d] = hcar;
        if (ctx) {
            if (d == 0 && t0 + 32 == seq_end) p->out[(size_t)NTOK * DM + (size_t)(t0 >> 8) * 1024 + gcl] = sa[(size_t)chunk * 512] * hcar + sb[(size_t)chunk * 512];
            if (d == 1 && t0 == seq_start) p->out[(size_t)NTOK * DM + (size_t)(t0 >> 8) * 1024 + 512 + gcl] = sa[(size_t)chunk * 512] * hcar + sb[(size_t)chunk * 512];
        }
    }
    float ov[2][4][4];
#pragma unroll
    for (int nt = 0; nt < 4; ++nt) { const float cf = shfl_f(car[0], 16 * nt + fr), cbk = shfl_f(car[1], 16 * nt + fr);
#pragma unroll
        for (int mt = 0; mt < 2; ++mt) { hs[mt][nt] = (f32x4){bflo(hsw[mt][nt].x), bfhi(hsw[mt][nt].x), bflo(hsw[mt][nt].y), bfhi(hsw[mt][nt].y)};
            const float af0 = f16lo(acf[mt][nt].x), af1 = f16hi(acf[mt][nt].x), af2 = f16lo(acf[mt][nt].y), af3 = f16hi(acf[mt][nt].y);
            const float ab0 = f16lo(acb[mt][nt].x), ab1 = f16hi(acb[mt][nt].x), ab2 = f16lo(acb[mt][nt].y), ab3 = f16hi(acb[mt][nt].y);
            ov[mt][nt][0] = geluf_(bf2f(yv[mt][nt][0])) * (hs[mt][nt][0] + af0 * cf + ab0 * cbk);
            ov[mt][nt][1] = geluf_(bf2f(yv[mt][nt][1])) * (hs[mt][nt][1] + af1 * cf + ab1 * cbk);
            ov[mt][nt][2] = geluf_(bf2f(yv[mt][nt][2])) * (hs[mt][nt][2] + af2 * cf + ab2 * cbk);
            ov[mt][nt][3] = geluf_(bf2f(yv[mt][nt][3])) * (hs[mt][nt][3] + af3 * cf + ab3 * cbk); } }
#pragma unroll
    for (int mt = 0; mt < 2; ++mt)
#pragma unroll
        for (int jj = 0; jj < 4; ++jj) { float s = 0.f;
#pragma unroll
            for (int nt = 0; nt < 4; ++nt) s += ov[mt][nt][jj] * ov[mt][nt][jj];
            s += shfl_f(s, lane ^ 1); s += shfl_f(s, lane ^ 2); s += shfl_f(s, lane ^ 4); s += shfl_f(s, lane ^ 8);
            if (fr == 0) sx[(16 * mt + 4 * fq + jj) * 8 + wave] = s; }
    __syncthreads();
    bf16_t* ob = (bf16_t*)(p->ws + WS_H1);
    float gl[4];
#pragma unroll
    for (int nt = 0; nt < 4; ++nt) gl[nt] = p->in[19][h * 64 + 16 * nt + fr];
#pragma unroll
    for (int mt = 0; mt < 2; ++mt)
#pragma unroll
        for (int jj = 0; jj < 4; ++jj) { const int tl = 16 * mt + 4 * fq + jj; const f32x4 s0 = *(const LAS f32x4*)(sx + tl * 8), s1 = *(const LAS f32x4*)(sx + tl * 8 + 4);
            const float tot = ((s0[0] + s0[1]) + (s0[2] + s0[3])) + ((s1[0] + s1[1]) + (s1[2] + s1[3]));
            const float inv = __builtin_amdgcn_rsqf(tot * (1.0f / 512.0f) + EPS);
#pragma unroll
            for (int nt = 0; nt < 4; ++nt) { const float o = ov[mt][nt][jj] * inv * gl[nt]; const unsigned w = cvt_pk_bf16(o, o);
                ob[(size_t)(t0 + tl) * DM + h * 64 + 16 * nt + fr] = (bf16_t)(w & 0xffffu); } }
    __syncthreads();
}

__device__ __forceinline__ void phase2(KP p, LAS unsigned char* lds, const int wave) {
    constexpr int NSGU = 384, NLRU = 384;
    const int b = blockIdx.x, G = gridDim.x;
    if (G == 256) {
        lru_scan_item(p, lds, b, wave);
        if (b < 128) lru_scan_item(p, lds, 256 + b, wave);
        else { __syncthreads(); for (int i = 0; i < 3; ++i) sgu_item(p, lds, 3 * (b - 128) + i, wave); }
    } else {
        for (int it = b; it < NSGU + NLRU; it += G) { __syncthreads(); if (it < NLRU) lru_scan_item(p, lds, it, wave); else sgu_item(p, lds, it - NLRU, wave); }
    }
}

__device__ __forceinline__ void sgu_norm_item(KP p, int item, const int wave, const int lane) {
    const int row0 = item * 32 + wave * 4;
    const bf16_t* osgu = (const bf16_t*)(p->ws + WS_OSGU); const float* sgp = (const float*)(p->ws + WS_SGP); bf16_t* ob = (bf16_t*)(p->ws + WS_H1);
    const f32x4 g0 = *(const f32x4*)(p->in[20] + 8 * lane), g1 = *(const f32x4*)(p->in[20] + 8 * lane + 4);
#pragma unroll
    for (int r = 0; r < 4; ++r) { const int row = row0 + r; const f32x4 s = *(const f32x4*)(sgp + (size_t)row * 4);
        const float inv = __builtin_amdgcn_rsqf(((s[0] + s[1]) + (s[2] + s[3])) * (1.0f / 512.0f) + EPS);
        const u32x4 ow = *(const u32x4*)(osgu + (size_t)row * 512 + 8 * lane);
        const f32x4 a = (f32x4){bflo(ow.x), bfhi(ow.x), bflo(ow.y), bfhi(ow.y)} * inv * g0, c = (f32x4){bflo(ow.z), bfhi(ow.z), bflo(ow.w), bfhi(ow.w)} * inv * g1;
        u32x4 w; w.x = cvt_pk_bf16(a[0], a[1]); w.y = cvt_pk_bf16(a[2], a[3]); w.z = cvt_pk_bf16(c[0], c[1]); w.w = cvt_pk_bf16(c[2], c[3]);
        *(u32x4*)(ob + (size_t)row * DM + 512 + 8 * lane) = w; }
}

__device__ __forceinline__ void phase3(KP p, LAS unsigned char* lds, const int wave) {
    const int lane = lane_id();
    constexpr int NLRU = 384, NNRM = 384;
    const int b = blockIdx.x, G = gridDim.x;
    if (G == 256) {
        if (b >= 128) for (int i = 0; i < 3; ++i) sgu_norm_item(p, 3 * (b - 128) + i, wave, lane);
        lru_fix_item(p, lds, b, wave);
        if (b < 128) lru_fix_item(p, lds, 256 + b, wave);
    } else {
        for (int it = b; it < NLRU + NNRM; it += G) { if (it < NLRU) lru_fix_item(p, lds, it, wave); else sgu_norm_item(p, it - NLRU, wave, lane); }
    }
}

__device__ __forceinline__ void phase7(KP p, const int wave) {
    const int lane = lane_id();
    const float* ssq4 = (const float*)(p->ws + WS_SSQ4);
    f32x4 fn[4];
#pragma unroll
    for (int i = 0; i < 4; ++i) fn[i] = *(const f32x4*)(p->in[26] + 256 * i + 4 * lane);
    for (int it = blockIdx.x; it < NTOK / 32; it += gridDim.x) {
#pragma unroll
        for (int r = 0; r < 4; ++r) { const int row = it * 32 + wave * 4 + r; const float* sp = ssq4 + (size_t)row * 16;
            const f32x4 s0 = *(const f32x4*)sp, s1 = *(const f32x4*)(sp + 4), s2 = *(const f32x4*)(sp + 8), s3 = *(const f32x4*)(sp + 12);
            const f32x4 st = (s0 + s1) + (s2 + s3);
            const float inv = __builtin_amdgcn_rsqf(((st[0] + st[1]) + (st[2] + st[3])) * (1.0f / 1024.0f) + EPS);
            float* op = p->out + (size_t)row * DM;
#pragma unroll
            for (int i = 0; i < 4; ++i) { const f32x4 v = *(const f32x4*)(op + 256 * i + 4 * lane); *(f32x4*)(op + 256 * i + 4 * lane) = v * inv * fn[i]; } }
    }
}

#define XB_TMO      128
#define XB_XCNT(j)  (256  + 64 * (j))
#define XB_XSUB(j)  (1280 + 64 * (j))
#define XB_XGEN(j)  (2304 + 64 * (j))
#define XB_TOP      3328
#define XB_TOPGEN   3392
#define XCD_BAR_WORDS 3456
#define XB_SPIN_CAP (1u << 18)
__device__ __forceinline__ unsigned xb_ld(unsigned* p)              { return __hip_atomic_load(p, __ATOMIC_RELAXED, __HIP_MEMORY_SCOPE_AGENT); }
__device__ __forceinline__ unsigned xb_add(unsigned* p, unsigned v) { return __hip_atomic_fetch_add(p, v, __ATOMIC_RELAXED, __HIP_MEMORY_SCOPE_AGENT); }
__device__ __forceinline__ unsigned xb_xcc_id() { return (unsigned)__builtin_amdgcn_s_getreg((3 << 11) | 20) & 0xFu; }
#define XB_SPIN(cond, bar) do { unsigned _sp = 0; while (cond) { __builtin_amdgcn_s_sleep(1); \
    if ((++_sp & 255u) == 0u) { if (xb_ld(&(bar)[XB_TMO])) break; if (_sp > XB_SPIN_CAP) { atomicAdd(&(bar)[XB_TMO], 1u); break; } } } } while (0)
__device__ __forceinline__ void xcd_barrier_complete(unsigned* bar, unsigned x, unsigned& nloc, unsigned& nx) {
    const unsigned G = gridDim.x;
    unsigned sum, cnt, mine, sp = 0u;
    for (;;) {
        sum = 0u; cnt = 0u; mine = 0u;
#pragma unroll
        for (unsigned j = 0; j < 16; ++j) { const unsigned c = xb_ld(&bar[XB_XCNT(j)]); sum += c; cnt += (c > 0u) ? 1u : 0u; mine = (j == x) ? c : mine; }
        if (sum == G) break;
        __builtin_amdgcn_s_sleep(1);
        if ((++sp & 255u) == 0u) { if (xb_ld(&bar[XB_TMO])) break; if (sp > XB_SPIN_CAP) { atomicAdd(&bar[XB_TMO], 1u); break; } }
    }
    nloc = mine > 0u ? mine : 1u; nx = cnt > 0u ? cnt : 1u;
}
__device__ __forceinline__ void xcd_barrier(unsigned* bar, const unsigned x, volatile LAS unsigned* st, const bool leader) {
    asm volatile("s_waitcnt vmcnt(0)" ::: "memory");
    __syncthreads();
    if (leader) {
        __builtin_amdgcn_s_waitcnt(0);
        unsigned nloc = st[0], nx = st[1];
        if (nloc == 0u) { xcd_barrier_complete(bar, x, nloc, nx); st[0] = nloc; st[1] = nx; }
        const unsigned old = xb_add(&bar[XB_XSUB(x)], 1u);
        const unsigned gen = old / nloc;
        if (old + 1u == (gen + 1u) * nloc) {
            __builtin_amdgcn_fence(__ATOMIC_RELEASE, "agent");
            asm volatile("s_waitcnt vmcnt(0)" ::: "memory");
            const unsigned og = xb_add(&bar[XB_TOP], 1u);
            const unsigned tg = og / nx;
            if (og + 1u == (tg + 1u) * nx) xb_add(&bar[XB_TOPGEN], 1u);
            else XB_SPIN(xb_ld(&bar[XB_TOPGEN]) == tg, bar);
            __builtin_amdgcn_fence(__ATOMIC_ACQUIRE, "agent");
            xb_add(&bar[XB_XGEN(x)], 1u);
            asm volatile("s_waitcnt vmcnt(0)" ::: "memory");
        } else {
            XB_SPIN(xb_ld(&bar[XB_XGEN(x)]) == gen, bar);
            __builtin_amdgcn_fence(__ATOMIC_ACQUIRE, "agent");
            asm volatile("s_waitcnt vmcnt(0)" ::: "memory");
        }
    }
    __syncthreads();
}

__global__ void __launch_bounds__(NTHREADS, 2) fwd_kernel(P p_unused) {
    extern __shared__ __attribute__((aligned(16))) unsigned char lds_raw[];
    LAS unsigned char* lds = (LAS unsigned char*)lds_raw;
    cg::grid_group grid = cg::this_grid();
    int lo, hi; { KP q = kargs(); lo = q->ph_lo; hi = q->ph_hi; }
    const int G = gridDim.x, bx = blockIdx.x;
    const int wave = __builtin_amdgcn_readfirstlane(threadIdx.x >> 6);
#ifndef REPMASK
#define REPMASK 0
#endif
#define REPS(k) (((REPMASK >> (k)) & 1) ? 2 : 1)
#define IN(k) (lo <= (k) && (k) < hi)
    if (lo < 0) grid.sync();
    unsigned* bar; { KP q = kargs(); bar = (unsigned*)(q->ws + WS_BAR); }
    volatile LAS unsigned* bst = (volatile LAS unsigned*)(lds + EX_OFF + 8192);
    const bool leader = (wave == 0) && (lane_id() == 0);
    const unsigned xcc = xb_xcc_id();
    if (leader) { bst[0] = 0u; bst[1] = 0u; if (lo + 1 < hi) (void)xb_add(&bar[XB_XCNT(xcc)], 1u); }
    __syncthreads();
#define SEAM(k) do { if (IN(k) && IN((k) + 1)) xcd_barrier(bar, xcc, bst, leader); } while (0)
    if (IN(0)) for (int rep_ = 0; rep_ < REPS(0); ++rep_) { KP p = kargs(); phase0(p, lds, wave); }
    SEAM(0);
    if (IN(1)) for (int rep_ = 0; rep_ < REPS(1); ++rep_) { KP p = kargs(); phase1(p, wave); }
    SEAM(1);
    if (IN(2)) for (int rep_ = 0; rep_ < REPS(2); ++rep_) { KP p = kargs(); pg8::Gemm g{(const bf16_t*)(p->ws + WS_H1), (const bf16_t*)(p->ws + WS_BT1), NTOK, DIN, DM}; pg8::StaticOrder S; S.init(NTOK, DIN, G, bx, 192);
        EpiZ<3> E{(bf16_t*)(p->ws + WS_Z)}; pg8::gemm_phase<EpiZ<3>, 3>(lds, g, S, E, wave); }
    SEAM(2);
    if (IN(3)) for (int rep_ = 0; rep_ < REPS(3); ++rep_) { KP p = kargs(); phase2(p, lds, wave); }
    SEAM(3);
    if (IN(4)) for (int rep_ = 0; rep_ < REPS(4); ++rep_) { KP p = kargs(); phase3(p, lds, wave); }
    SEAM(4);
    if (IN(5)) for (int rep_ = 0; rep_ < REPS(5); ++rep_) { KP p = kargs(); pg8::Gemm g{(const bf16_t*)(p->ws + WS_H1), (const bf16_t*)(p->ws + WS_BT2), NTOK, DM, DM}; pg8::StaticOrder S; S.init(NTOK, DM, G, bx, 192);
        EpiG2<3> E{p->in[0], p->in[1], (const float*)(p->ws + WS_MOD), p->in[6], (float*)(p->ws + WS_X1), (bf16_t*)(p->ws + WS_H2), (float*)(p->ws + WS_SSQ2)}; pg8::gemm_phase<EpiG2<3>, 3>(lds, g, S, E, wave); }
    SEAM(5);
    if (IN(6)) for (int rep_ = 0; rep_ < REPS(6); ++rep_) { KP p = kargs(); pg8::Gemm g{(const bf16_t*)(p->ws + WS_H2), (const bf16_t*)(p->ws + WS_BT3), NTOK, DFF2, DM}; pg8::StaticOrder S; S.init(NTOK, DFF2, G, bx);
        EpiG3 E{(const float*)(p->ws + WS_SSQ2), (const float*)(p->ws + WS_SHW), p->in[23], p->in[24], (bf16_t*)(p->ws + WS_ACT), (LAS float*)(lds + EX_OFF)}; pg8::gemm_phase<EpiG3>(lds, g, S, E, wave); }
    SEAM(6);
    if (IN(7)) for (int rep_ = 0; rep_ < REPS(7); ++rep_) { KP p = kargs(); pg8::Gemm g{(const bf16_t*)(p->ws + WS_ACT), (const bf16_t*)(p->ws + WS_BT4), NTOK, DM, DFF}; pg8::StaticOrder S; S.init(NTOK, DM, G, bx, 192);
        EpiG4<3> E{(const float*)(p->ws + WS_MOD), (const float*)(p->ws + WS_X1), p->in[26], p->out, (unsigned*)(p->ws + WS_SGP), (unsigned*)(p->ws + WS_BAR + 16384)}; pg8::gemm_phase<EpiG4<3>, 3>(lds, g, S, E, wave); }
#undef IN
#undef SEAM
}

extern "C" void kernel_launch(void* const* d_in, const int* in_sizes, int n_in, void* d_out, int out_size, void* d_ws, size_t ws_size, hipStream_t stream) {
    static int grid = 0;
    if (grid == 0) {
        int dev = 0, cus = 0, per_cu = 0;
        hipGetDevice(&dev);
        hipDeviceGetAttribute(&cus, hipDeviceAttributeMultiprocessorCount, dev);
        hipFuncSetAttribute((const void*)fwd_kernel, hipFuncAttributeMaxDynamicSharedMemorySize, LDS_BYTES);
        hipOccupancyMaxActiveBlocksPerMultiprocessor(&per_cu, (const void*)fwd_kernel, NTHREADS, LDS_BYTES);
        if (per_cu < 1) { fprintf(stderr, "occupancy query says %d blocks per CU\n", per_cu); per_cu = 1; }
        grid = cus * per_cu;
        if (ws_size < WS_END) fprintf(stderr, "workspace too small: %zu < %zu\n", ws_size, (size_t)WS_END);
    }
    P p{};
    for (int i = 0; i < 27; ++i) p.in[i] = (const float*)d_in[i];
    p.out = (float*)d_out; p.ws = (unsigned char*)d_ws;
#if ONE_LAUNCH
    (void)hipMemsetAsync((char*)d_ws + WS_BAR, 0, 16384 + 64 * 256, stream);
    p.ph_lo = 0; p.ph_hi = 8;
    void* args[] = {&p};
    hipError_t e = hipLaunchCooperativeKernel((const void*)fwd_kernel, dim3(grid), dim3(NTHREADS), args, LDS_BYTES, stream);
    if (e != hipSuccess) fprintf(stderr, "cooperative launch failed: %s (grid %d)\n", hipGetErrorString(e), grid);
#else
    for (int k = 0; k < 8; ++k) { p.ph_lo = k; p.ph_hi = k + 1; hipLaunchKernelGGL(fwd_kernel, dim3(grid), dim3(NTHREADS), LDS_BYTES, stream, p); }
#endif
}
```
